# Optimizing an MI355X kernel written in HIP

```python
import jax, jax.numpy as jnp
from jax import lax
import numpy as np

D_MODEL = 2048
BATCH = 8
SEQ = 4096
DEPTH = 1

CHUNK = 64
EPS = 1e-6
D_MIX = D_MODEL
GMLP_BLOCK = 128
GMLP_WIDTH = D_MIX // 2
GMLP_GROUPS = 8
GMLP_GROUP_DIM = GMLP_WIDTH // GMLP_GROUPS
ATT_WIDTH = D_MIX - GMLP_WIDTH
N_HEADS = 16
HEAD_DIM = ATT_WIDTH // N_HEADS
KV_LATENT = 256
IDX_HEADS = 8
IDX_DIM = 64
TOPK_MAX = 256
Q_BLOCK = 128
ROPE_THETA = 10000.0
IN_SPLIT_SIZES = (GMLP_WIDTH, GMLP_WIDTH, ATT_WIDTH, KV_LATENT, IDX_HEADS * IDX_DIM, IDX_DIM, IDX_HEADS)
IN_COLS = sum(IN_SPLIT_SIZES)
N_EXPERT_GROUPS = 4
EXPERTS_PER_GROUP = 8
N_EXPERTS = N_EXPERT_GROUPS * EXPERTS_PER_GROUP
TOP_K_IN_GROUP = 2
D_EXPERT = 1024
MOE_BLOCK = 128

kernel_name = "hybrid_gmlp_dsa_hmoe_block"


def rms_norm(x, g):
    xf = x.astype(jnp.float32)
    y = xf * lax.rsqrt(jnp.mean(xf * xf, axis=-1, keepdims=True) + EPS)
    return (y * g).astype(x.dtype)


def layer_norm(x, g, b):
    xf = x.astype(jnp.float32)
    mu = jnp.mean(xf, axis=-1, keepdims=True)
    var = jnp.mean(jnp.square(xf - mu), axis=-1, keepdims=True)
    return ((xf - mu) * lax.rsqrt(var + EPS) * g + b).astype(x.dtype)


def rope(x, pos):
    half = x.shape[-1] // 2
    freqs = ROPE_THETA ** (-jnp.arange(half, dtype=jnp.float32) / half)
    ang = pos.astype(jnp.float32)[..., None] * freqs
    cos = jnp.cos(ang)[:, :, None, :]
    sin = jnp.sin(ang)[:, :, None, :]
    x1, x2 = x[..., :half], x[..., half:]
    return jnp.concatenate([x1 * cos - x2 * sin, x1 * sin + x2 * cos], axis=-1).astype(x.dtype)


def gmlp_spatial_gate(u, v, v_norm_g, v_norm_b, w_sp, b_sp):
    B, S, _ = u.shape
    nb = S // GMLP_BLOCK
    v = v.reshape(B, nb, GMLP_BLOCK, GMLP_GROUPS, GMLP_GROUP_DIM)
    v = layer_norm(v, v_norm_g, v_norm_b)
    pos = jnp.arange(GMLP_BLOCK)
    mask = (pos[:, None] // CHUNK) >= (pos[None, :] // CHUNK)
    w = jnp.where(mask[None], w_sp, jnp.zeros_like(w_sp))
    z = jnp.einsum('gij,bnjgc->bnigc', w, v) + b_sp.T[None, None, :, :, None]
    return u * z.reshape(B, S, GMLP_WIDTH)


def dsa_attention(q, c_kv, q_idx, k_idx, w_idx, positions, kv_norm_g, w_uk, w_uv, kidx_norm_g):
    B, S = q.shape[0], q.shape[1]
    top_k = min(TOPK_MAX, S // 4)
    c_kv = rms_norm(c_kv, kv_norm_g)
    k = rope((c_kv @ w_uk)[:, :, None, :], positions)[:, :, 0, :]
    v = c_kv @ w_uv
    q = rope(q, positions)
    q_idx = rope(q_idx, positions)
    k_idx = rope(rms_norm(k_idx, kidx_norm_g)[:, :, None, :], positions)[:, :, 0, :]
    w_idx = w_idx.astype(jnp.float32) * (IDX_HEADS ** -0.5) * (IDX_DIM ** -0.5)
    key_chunk = jnp.arange(S) // CHUNK

    def query_block(qb):
        start = qb * Q_BLOCK
        q_blk = lax.dynamic_slice_in_dim(q, start, Q_BLOCK, axis=1)
        qi_blk = lax.dynamic_slice_in_dim(q_idx, start, Q_BLOCK, axis=1)
        wi_blk = lax.dynamic_slice_in_dim(w_idx, start, Q_BLOCK, axis=1)
        q_chunk = (start + jnp.arange(Q_BLOCK)) // CHUNK
        admissible = key_chunk[None, :] <= q_chunk[:, None]
        idx_logits = jnp.einsum('bqhd,bsd->bqhs', qi_blk, k_idx).astype(jnp.float32)
        score = jnp.einsum('bqh,bqhs->bqs', wi_blk, jax.nn.relu(idx_logits))
        score = jnp.where(admissible[None], score, -jnp.inf)
        top_val, top_idx = lax.top_k(score, top_k)
        valid = jnp.isfinite(top_val)
        k_sel = jax.vmap(lambda kb, ib: kb[ib])(k, top_idx)
        v_sel = jax.vmap(lambda vb, ib: vb[ib])(v, top_idx)
        s = jnp.einsum('bqhd,bqkd->bqhk', q_blk, k_sel).astype(jnp.float32) * (HEAD_DIM ** -0.5)
        s = jnp.where(valid[:, :, None, :], s, -jnp.inf)
        p = jax.nn.softmax(s, axis=-1).astype(v.dtype)
        return jnp.einsum('bqhk,bqkd->bqhd', p, v_sel)

    out = lax.map(query_block, jnp.arange(S // Q_BLOCK))
    return out.transpose(1, 0, 2, 3, 4).reshape(B, S, ATT_WIDTH)


def hierarchical_moe(h, w_group, b_group, w_expert, b_expert, w1, w3, w2):
    T, D = h.shape
    hf = h.astype(jnp.float32)
    g_prob = jax.nn.softmax(hf @ w_group + b_group, axis=-1)
    g_p, g_idx = lax.top_k(g_prob, 1)
    e_logits = (hf @ w_expert + b_expert).reshape(T, N_EXPERT_GROUPS, EXPERTS_PER_GROUP)
    e_logits = jnp.take_along_axis(e_logits, g_idx[:, :, None], axis=1)[:, 0]
    e_prob = jax.nn.softmax(e_logits, axis=-1)
    e_p, e_idx = lax.top_k(e_prob, TOP_K_IN_GROUP)
    e_p = e_p / jnp.sum(e_p, axis=-1, keepdims=True)
    weights = g_p * e_p
    experts = g_idx * EXPERTS_PER_GROUP + e_idx

    M = T * TOP_K_IN_GROUP
    e_flat = experts.reshape(M)
    w_flat = weights.reshape(M).astype(h.dtype)
    tok_flat = jnp.arange(M, dtype=jnp.int32) // TOP_K_IN_GROUP
    order = jnp.argsort(e_flat)
    e_sorted = e_flat[order]
    counts = jnp.zeros((N_EXPERTS,), jnp.int32).at[e_flat].add(1)
    starts = jnp.cumsum(counts) - counts
    padded = (counts + MOE_BLOCK - 1) // MOE_BLOCK * MOE_BLOCK
    pends = jnp.cumsum(padded)
    pstarts = pends - padded
    dest = pstarts[e_sorted] + (jnp.arange(M, dtype=jnp.int32) - starts[e_sorted])
    n_blocks = M // MOE_BLOCK + N_EXPERTS
    n_slots = n_blocks * MOE_BLOCK
    slot_tok = jnp.zeros((n_slots,), jnp.int32).at[dest].set(tok_flat[order])
    slot_w = jnp.zeros((n_slots,), h.dtype).at[dest].set(w_flat[order])
    block_start = jnp.arange(n_blocks, dtype=jnp.int32) * MOE_BLOCK
    block_expert = jnp.minimum(jnp.searchsorted(pends, block_start, side='right'), N_EXPERTS - 1)

    def expert_block(args):
        e, toks, wts = args
        xb = h[toks]
        y = (jax.nn.silu(xb @ w1[e]) * (xb @ w3[e])) @ w2[e]
        return y * wts[:, None]

    ys = lax.map(expert_block, (block_expert,
                                slot_tok.reshape(n_blocks, MOE_BLOCK),
                                slot_w.reshape(n_blocks, MOE_BLOCK)))
    return jnp.zeros_like(h).at[slot_tok].add(ys.reshape(n_slots, D))


def setup_inputs(seed: int = 0) -> dict:
    key = jax.random.key(seed)
    ks = jax.random.split(key, 32)

    def nrm(k, shape, scale):
        return jax.random.normal(k, shape, jnp.float32) * scale

    L = DEPTH
    offsets = jax.random.randint(ks[2], (BATCH, 1), 0, 64, dtype=jnp.int32) * CHUNK
    return {
        "x": nrm(ks[0], (BATCH, SEQ, D_MODEL), 1.0),
        "c": nrm(ks[1], (BATCH, D_MODEL), 1.0),
        "positions": offsets + jnp.arange(SEQ, dtype=jnp.int32)[None, :],
        "w_ada": nrm(ks[3], (L, D_MODEL, 6 * D_MODEL), 0.5 * D_MODEL ** -0.5),
        "b_ada": nrm(ks[4], (L, 6 * D_MODEL), 0.02),
        "norm1_g": 1.0 + nrm(ks[5], (L, D_MODEL), 0.02),
        "w_in": nrm(ks[6], (L, D_MODEL, IN_COLS), D_MODEL ** -0.5),
        "v_norm_g": 1.0 + nrm(ks[7], (L, GMLP_GROUPS, GMLP_GROUP_DIM), 0.02),
        "v_norm_b": nrm(ks[8], (L, GMLP_GROUPS, GMLP_GROUP_DIM), 0.02),
        "w_sp": nrm(ks[9], (L, GMLP_GROUPS, GMLP_BLOCK, GMLP_BLOCK), GMLP_BLOCK ** -0.5),
        "b_sp": 1.0 + nrm(ks[10], (L, GMLP_GROUPS, GMLP_BLOCK), 0.02),
        "kv_norm_g": 1.0 + nrm(ks[11], (L, KV_LATENT), 0.02),
        "w_uk": nrm(ks[12], (L, KV_LATENT, HEAD_DIM), KV_LATENT ** -0.5),
        "w_uv": nrm(ks[13], (L, KV_LATENT, HEAD_DIM), KV_LATENT ** -0.5),
        "kidx_norm_g": 1.0 + nrm(ks[14], (L, IDX_DIM), 0.02),
        "gnorm_a_g": 1.0 + nrm(ks[15], (L, GMLP_WIDTH), 0.02),
        "gnorm_b_g": 1.0 + nrm(ks[16], (L, ATT_WIDTH), 0.02),
        "w_out": nrm(ks[17], (L, D_MIX, D_MODEL), D_MIX ** -0.5),
        "norm2_g": 1.0 + nrm(ks[18], (L, D_MODEL), 0.02),
        "w_group": nrm(ks[19], (L, D_MODEL, N_EXPERT_GROUPS), D_MODEL ** -0.5),
        "b_group": nrm(ks[20], (L, N_EXPERT_GROUPS), 0.01),
        "w_expert": nrm(ks[21], (L, D_MODEL, N_EXPERTS), D_MODEL ** -0.5),
        "b_expert": nrm(ks[22], (L, N_EXPERTS), 0.01),
        "w1": nrm(ks[23], (L, N_EXPERTS, D_MODEL, D_EXPERT), D_MODEL ** -0.5),
        "w3": nrm(ks[24], (L, N_EXPERTS, D_MODEL, D_EXPERT), D_MODEL ** -0.5),
        "w2": nrm(ks[25], (L, N_EXPERTS, D_EXPERT, D_MODEL), D_EXPERT ** -0.5),
        "final_g": 1.0 + nrm(ks[26], (D_MODEL,), 0.02),
    }


def reference(x, c, positions, w_ada, b_ada, norm1_g, w_in, v_norm_g, v_norm_b, w_sp, b_sp,
              kv_norm_g, w_uk, w_uv, kidx_norm_g, gnorm_a_g, gnorm_b_g, w_out, norm2_g,
              w_group, b_group, w_expert, b_expert, w1, w3, w2, final_g):
    B, S, D = x.shape
    split_points = [int(p) for p in np.cumsum(IN_SPLIT_SIZES)[:-1]]
    for l in range(DEPTH):
        mod = jax.nn.silu(c) @ w_ada[l] + b_ada[l]
        shift1, scale1, gate1, shift2, scale2, gate2 = [m[:, None, :] for m in jnp.split(mod, 6, axis=-1)]

        h = rms_norm(x, norm1_g[l]) * (1.0 + scale1) + shift1
        proj = h @ w_in[l]
        u, v, q, c_kv, q_idx, k_idx, w_idx = jnp.split(proj, split_points, axis=-1)
        y_a = gmlp_spatial_gate(jax.nn.gelu(u), jax.nn.gelu(v), v_norm_g[l], v_norm_b[l], w_sp[l], b_sp[l])
        y_b = dsa_attention(q.reshape(B, S, N_HEADS, HEAD_DIM), c_kv,
                            q_idx.reshape(B, S, IDX_HEADS, IDX_DIM), k_idx, w_idx, positions,
                            kv_norm_g[l], w_uk[l], w_uv[l], kidx_norm_g[l])
        y = jnp.concatenate([rms_norm(y_a, gnorm_a_g[l]), rms_norm(y_b, gnorm_b_g[l])], axis=-1)
        x = x + gate1 * (y @ w_out[l])

        h2 = rms_norm(x, norm2_g[l]) * (1.0 + scale2) + shift2
        moe = hierarchical_moe(h2.reshape(B * S, D), w_group[l], b_group[l], w_expert[l], b_expert[l],
                               w1[l], w3[l], w2[l])
        x = x + gate2 * moe.reshape(B, S, D)
    return rms_norm(x, final_g)
```

```cpp
#include <hip/hip_runtime.h>
#include <cstdio>
#include <cstdint>
#include <cmath>

#define LAS __attribute__((address_space(3)))
typedef unsigned short bf16;
typedef short bf16x8 __attribute__((ext_vector_type(8)));
typedef float f32x4 __attribute__((ext_vector_type(4)));
typedef float f32x2 __attribute__((ext_vector_type(2)));
typedef unsigned u32x4 __attribute__((ext_vector_type(4)));
typedef unsigned u32x2 __attribute__((ext_vector_type(2)));

constexpr int NB = 8, SEQ = 4096, DM = 2048, NT = NB * SEQ;
constexpr int NPROJ = 4096, INC = 3912;
constexpr int C_U = 0, C_V = 1024, C_Q = 2048, C_CKV = 3072, C_QI = 3328, C_KI = 3840, C_WI = 3904;
constexpr int NE = 32, DE = 1024;
constexpr int SLOT_ROWS = 65536 + 32 * 256;
constexpr float EPS = 1e-6f;
constexpr int NPH = 12;

constexpr size_t MiB = 1u << 20;
constexpr size_t WS_CTL = 0, CTL_BYTES = 1 * MiB;
constexpr size_t WS_MOD = 1 * MiB;
constexpr size_t WS_CS = 2 * MiB;
constexpr size_t WS_WIN = 10 * MiB;
constexpr size_t WS_WOUT = 26 * MiB;
constexpr size_t WS_WSP = 34 * MiB;
constexpr size_t WS_WUKV = 34 * MiB + 256 * 1024;
constexpr size_t WS_WR = 34 * MiB + 512 * 1024;
constexpr size_t WS_KB = 35 * MiB, WS_VB = 39 * MiB, WS_KIDX = 43 * MiB;
constexpr size_t WS_SSQ = 47 * MiB;
constexpr size_t WS_LIST = 48 * MiB;
constexpr size_t WS_TOK = 52 * MiB;
constexpr size_t WS_W13 = 56 * MiB;
constexpr size_t WS_W2 = 312 * MiB;
constexpr size_t WS_PROJ = 440 * MiB;
constexpr size_t WS_H = 696 * MiB;
constexpr size_t WS_Y = 824 * MiB;
constexpr size_t WS_ACT = WS_PROJ;
constexpr size_t WS_YMOE = 584 * MiB;
constexpr size_t WS_END = 952 * MiB;
constexpr int CW_BAR = 4096, CW_CNT = 16384;

constexpr int LDS_BYTES = 163840 - 512;
constexpr int LDS_MISC = LDS_BYTES - 64;

struct P {
    const float *x, *c; const int* pos;
    const float *w_ada, *b_ada, *norm1_g, *w_in, *v_norm_g, *v_norm_b, *w_sp, *b_sp, *kv_norm_g, *w_uk, *w_uv, *kidx_norm_g, *gnorm_a_g, *gnorm_b_g, *w_out, *norm2_g,
        *w_group, *b_group, *w_expert, *b_expert, *w1, *w3, *w2, *final_g;
    float* out; unsigned char* ws;
    int ph_lo, ph_hi;
    float freqs[32];
};

__device__ __forceinline__ unsigned f2bf(float f) { unsigned u = __builtin_bit_cast(unsigned, f); return (u + 0x7fffu + ((u >> 16) & 1u)) >> 16; }
__device__ __forceinline__ unsigned pk2(float lo, float hi) { return f2bf(lo) | (f2bf(hi) << 16); }
__device__ __forceinline__ float bflo(unsigned w) { return __builtin_bit_cast(float, w << 16); }
__device__ __forceinline__ float bfhi(unsigned w) { return __builtin_bit_cast(float, w & 0xffff0000u); }
__device__ __forceinline__ float bf2f(bf16 b) { return __builtin_bit_cast(float, ((unsigned)b) << 16); }
__device__ __forceinline__ float wave_sum(float v) {
#pragma unroll
    for (int o = 1; o < 64; o <<= 1) v += __shfl_xor(v, o);
    return v;
}
__device__ __forceinline__ float wave_max(float v) {
#pragma unroll
    for (int o = 1; o < 64; o <<= 1) v = fmaxf(v, __shfl_xor(v, o));
    return v;
}
__device__ __forceinline__ float gelu_tanh(float x) {
    const float y = 0.7978845608028654f * (x + 0.044715f * x * x * x);
    const float e = __expf(2.f * y);
    const float t = 1.f - 2.f / (1.f + e);
    return 0.5f * x * (1.f + t);
}
__device__ __forceinline__ float silu_f(float x) { return x / (1.f + __expf(-x)); }
__device__ __forceinline__ void sincos_acc(float angf, float& s, float& c) {
    const double x = (double)angf;
    const double kd = rint(x * 0.6366197723675814);
    double r = fma(-kd, 1.5707963267948966, x);
    r = fma(-kd, 6.123233995736766e-17, r);
    const int q = (int)((long long)kd & 3);
    const double r2 = r * r;
    const double sp = r * (1.0 + r2 * (-1.0 / 6 + r2 * (1.0 / 120 + r2 * (-1.0 / 5040 + r2 * (1.0 / 362880 + r2 * (-1.0 / 39916800 + r2 * (1.0 / 6227020800.0)))))));
    const double cp = 1.0 + r2 * (-0.5 + r2 * (1.0 / 24 + r2 * (-1.0 / 720 + r2 * (1.0 / 40320 + r2 * (-1.0 / 3628800 + r2 * (1.0 / 479001600 + r2 * (-1.0 / 87178291200.0)))))));
    double ss, cc;
    if (q == 0) { ss = sp; cc = cp; } else if (q == 1) { ss = cp; cc = -sp; } else if (q == 2) { ss = -sp; cc = -cp; } else { ss = -cp; cc = sp; }
    s = (float)ss; c = (float)cc;
}

__device__ __forceinline__ void tr_item(const float* src, int ld, int nvalid, int k0, int n0, bf16* dst_n0, int ldd, const float* kscale, LAS float* scr, int lane) {
#pragma unroll 8
    for (int i = 0; i < 32; ++i) {
        const int kk = 2 * i + (lane >> 5), n = n0 + (lane & 31);
        float v = (n < nvalid) ? src[(size_t)(k0 + kk) * ld + n] : 0.f;
        if (kscale) v *= kscale[k0 + kk];
        scr[kk * 33 + (lane & 31)] = v;
    }
    asm volatile("s_waitcnt lgkmcnt(0)" ::: "memory");
    const int c = lane & 7;
#pragma unroll
    for (int j = 0; j < 4; ++j) {
        const int n = (lane >> 3) + 8 * j; const LAS float* s = scr + (8 * c) * 33 + n;
        u32x4 o; o.x = pk2(s[0 * 33], s[1 * 33]); o.y = pk2(s[2 * 33], s[3 * 33]); o.z = pk2(s[4 * 33], s[5 * 33]); o.w = pk2(s[6 * 33], s[7 * 33]);
        *(u32x4*)(dst_n0 + (size_t)n * ldd + k0 + 8 * c) = o;
    }
    asm volatile("s_waitcnt lgkmcnt(0)" ::: "memory");
}

__device__ __forceinline__ void ph_prep(const P& p, LAS unsigned char* lds) {
    const int tid = threadIdx.x, lane = tid & 63, wave = tid >> 6;
    const int gw = blockIdx.x * 8 + wave, NGW = gridDim.x * 8;
    unsigned char* ws = p.ws;
    LAS float* scr = (LAS float*)(lds + wave * 8704);
    constexpr int I_IN = 32 * 128, I_OUT = 32 * 64, I_13 = 64 * 1024, I_2 = 32 * 1024, I_UKV = 16;
    constexpr int NIT = I_IN + I_OUT + I_13 + I_2 + I_UKV;
    for (int it = gw; it < NIT; it += NGW) {
        int r = it;
        if (r < I_IN) { const int kb = r / 128, nb = r % 128; tr_item(p.w_in, INC, INC, 64 * kb, 32 * nb, (bf16*)(ws + WS_WIN) + (size_t)(32 * nb) * DM, DM, nullptr, scr, lane); continue; }
        r -= I_IN;
        if (r < I_OUT) { const int kb = r / 64, nb = r % 64; const int k0 = 64 * kb;
            tr_item(p.w_out, DM, DM, k0, 32 * nb, (bf16*)(ws + WS_WOUT) + (size_t)(32 * nb) * DM, DM, (k0 < 1024) ? p.gnorm_a_g : (p.gnorm_b_g - 1024), scr, lane); continue; }
        r -= I_OUT;
        if (r < I_13) { const int mat = r / 1024, q = r % 1024, e = mat >> 1, which = mat & 1, kb = q / 32, nb = q % 32; const int n0 = 32 * nb;
            const float* src = (which ? p.w3 : p.w1) + (size_t)e * DM * DE;
            bf16* dst = (bf16*)(ws + WS_W13) + ((size_t)(e * 8 + n0 / 128) * 256 + (n0 % 128) + which * 128) * DM;
            tr_item(src, DE, DE, 64 * kb, n0, dst - 0, DM, nullptr, scr, lane);
            continue; }
        r -= I_13;
        if (r < I_2) { const int e = r / 1024, q = r % 1024, kb = q / 64, nb = q % 64;
            tr_item(p.w2 + (size_t)e * DE * DM, DM, DM, 64 * kb, 32 * nb, (bf16*)(ws + WS_W2) + ((size_t)e * DM + 32 * nb) * DE, DE, nullptr, scr, lane); continue; }
        r -= I_2;
        { const int which = r / 8, q = r % 8, kb = q / 2, nb = q % 2;
          tr_item(which ? p.w_uv : p.w_uk, 64, 64, 64 * kb, 32 * nb, (bf16*)(ws + WS_WUKV) + (size_t)(which * 64 + 32 * nb) * 256, 256, p.kv_norm_g, scr, lane); }
    }
    const int gt = blockIdx.x * 512 + tid, NGT = gridDim.x * 512;
    for (int i = gt; i < 8 * 128 * 128; i += NGT) { const int ii = (i >> 7) & 127, j = i & 127; ((bf16*)(ws + WS_WSP))[i] = ((ii >> 6) >= (j >> 6)) ? (bf16)f2bf(p.w_sp[i]) : (bf16)0; }
    for (int i = gt; i < 48 * 2048; i += NGT) { const int n = i / 2048, k = i % 2048; float v = 0.f; if (n < 4) v = p.w_group[k * 4 + n]; else if (n < 36) v = p.w_expert[k * 32 + (n - 4)]; ((bf16*)(ws + WS_WR))[i] = (bf16)f2bf(v); }
    for (int i = gt; i < NT * 32; i += NGT) { const int tok = i >> 5, f = i & 31; const float ang = (float)p.pos[tok] * p.freqs[f]; float s, c; sincos_acc(ang, s, c); ((f32x2*)(ws + WS_CS))[i] = (f32x2){c, s}; }
    __syncthreads();
    LAS float* sl = (LAS float*)lds;
    LAS float* red = (LAS float*)(lds + 65536);
    for (int i = tid; i < 8 * 2048; i += 512) sl[i] = silu_f(p.c[i]);
    __syncthreads();
    for (int cb = blockIdx.x; cb < 256; cb += gridDim.x) {
        const int cg = tid % 12, kl = tid / 12, col0 = cb * 48 + 4 * cg;
        if (kl < 42) {
            f32x4 acc[8];
#pragma unroll
            for (int b = 0; b < 8; ++b) acc[b] = (f32x4){0.f, 0.f, 0.f, 0.f};
            for (int k = kl; k < 2048; k += 42) {
                const f32x4 w = *(const f32x4*)(p.w_ada + (size_t)k * 12288 + col0);
#pragma unroll
                for (int b = 0; b < 8; ++b) acc[b] += w * sl[b * 2048 + k];
            }
#pragma unroll
            for (int b = 0; b < 8; ++b)
#pragma unroll
                for (int e = 0; e < 4; ++e) red[(kl * 8 + b) * 48 + 4 * cg + e] = acc[b][e];
        }
        __syncthreads();
        if (tid < 384) { const int b = tid / 48, cc = tid % 48; float s = 0.f; for (int k = 0; k < 42; ++k) s += red[(k * 8 + b) * 48 + cc];
            ((float*)(ws + WS_MOD))[b * 12288 + cb * 48 + cc] = s + p.b_ada[cb * 48 + cc]; }
        __syncthreads();
    }
}

__device__ __forceinline__ void ph_h(const P& p) {
    const int tid = threadIdx.x, lane = tid & 63, wave = tid >> 6;
    const int gw = blockIdx.x * 8 + wave, NGW = gridDim.x * 8;
    const float* mod = (const float*)(p.ws + WS_MOD);
    bf16* H = (bf16*)(p.ws + WS_H);
    for (int m = gw; m < NT; m += NGW) {
        const int b = m >> 12;
        const f32x4* xr = (const f32x4*)(p.x + (size_t)m * DM) + lane;
        f32x4 v[8]; float ss = 0.f;
#pragma unroll
        for (int j = 0; j < 8; ++j) { v[j] = xr[64 * j]; ss += v[j].x * v[j].x + v[j].y * v[j].y + v[j].z * v[j].z + v[j].w * v[j].w; }
        const float rstd = 1.f / sqrtf(wave_sum(ss) * (1.f / DM) + EPS);
        u32x2* o = (u32x2*)(H + (size_t)m * DM) + lane;
#pragma unroll
        for (int j = 0; j < 8; ++j) {
            const int col = 4 * lane + 256 * j;
            const f32x4 g = *(const f32x4*)(p.norm1_g + col), sh = *(const f32x4*)(mod + b * 12288 + col), sc = *(const f32x4*)(mod + b * 12288 + 2048 + col);
            const f32x4 h = v[j] * rstd * g * (sc + 1.f) + sh;
            o[64 * j] = (u32x2){pk2(h.x, h.y), pk2(h.z, h.w)};
        }
    }
}

#define SG_LOOP(K, arow, brow, acc) \
    for (int k0 = 0; k0 < (K); k0 += 32) { bf16x8 af[4], bfr[4]; \
        _Pragma("unroll") for (int i = 0; i < 4; ++i) { af[i] = *(const bf16x8*)((arow)[i] + k0); bfr[i] = *(const bf16x8*)((brow)[i] + k0); } \
        _Pragma("unroll") for (int mi = 0; mi < 4; ++mi) _Pragma("unroll") for (int ni = 0; ni < 4; ++ni) (acc)[mi][ni] = __builtin_amdgcn_mfma_f32_16x16x32_bf16(bfr[ni], af[mi], (acc)[mi][ni], 0, 0, 0); }

__device__ __forceinline__ void ph_inproj(const P& p) {
    const int tid = threadIdx.x, lane = tid & 63, wave = tid >> 6, fr = lane & 15, fq = lane >> 4;
    const int gw = blockIdx.x * 8 + wave, NGW = gridDim.x * 8;
    const bf16* H = (const bf16*)(p.ws + WS_H); const bf16* W = (const bf16*)(p.ws + WS_WIN); bf16* PR = (bf16*)(p.ws + WS_PROJ);
    constexpr int NNT = 62;
    for (int u = gw; u < (NT / 64) * NNT; u += NGW) {
        const int mt = u / NNT, nt = u % NNT;
        const bf16* arow[4]; const bf16* brow[4];
#pragma unroll
        for (int i = 0; i < 4; ++i) { arow[i] = H + (size_t)(64 * mt + 16 * i + fr) * DM + 8 * fq; brow[i] = W + (size_t)(64 * nt + 16 * i + fr) * DM + 8 * fq; }
        f32x4 acc[4][4];
#pragma unroll
        for (int a = 0; a < 4; ++a)
#pragma unroll
            for (int b = 0; b < 4; ++b) acc[a][b] = (f32x4){0.f, 0.f, 0.f, 0.f};
        SG_LOOP(DM, arow, brow, acc)
#pragma unroll
        for (int mi = 0; mi < 4; ++mi)
#pragma unroll
            for (int ni = 0; ni < 4; ++ni) {
                const int row = 64 * mt + 16 * mi + fr, col = 64 * nt + 16 * ni + 4 * fq;
                f32x4 v = acc[mi][ni];
                if (col < C_Q) { v.x = gelu_tanh(v.x); v.y = gelu_tanh(v.y); v.z = gelu_tanh(v.z); v.w = gelu_tanh(v.w); }
                *(u32x2*)(PR + (size_t)row * NPROJ + col) = (u32x2){pk2(v.x, v.y), pk2(v.z, v.w)};
            }
    }
}

__device__ __forceinline__ void ph_gmlp(const P& p, LAS unsigned char* lds) {
    const int tid = threadIdx.x, lane = tid & 63, wave = tid >> 6;
    const bf16* PR = (const bf16*)(p.ws + WS_PROJ); const bf16* WSP = (const bf16*)(p.ws + WS_WSP); bf16* Y = (bf16*)(p.ws + WS_Y);
    LAS float* vn = (LAS float*)lds;
    LAS float* wl = (LAS float*)(lds + 65536);
    for (int u = blockIdx.x; u < NB * 32 * 8; u += gridDim.x) {
        const int g = u & 7, n = (u >> 3) & 31, b = u >> 8;
        const int tok0 = b * SEQ + n * 128;
        __syncthreads();
        for (int rr = 0; rr < 16; ++rr) {
            const int j = wave * 16 + rr;
            const bf16* vr = PR + (size_t)(tok0 + j) * NPROJ + C_V + g * 128;
            const float a0 = bf2f(vr[lane]), a1 = bf2f(vr[lane + 64]);
            const float mu = wave_sum(a0 + a1) * (1.f / 128.f);
            const float d0 = a0 - mu, d1 = a1 - mu;
            const float var = wave_sum(d0 * d0 + d1 * d1) * (1.f / 128.f);
            const float rs = 1.f / sqrtf(var + EPS);
            vn[j * 128 + lane] = d0 * rs * p.v_norm_g[g * 128 + lane] + p.v_norm_b[g * 128 + lane];
            vn[j * 128 + lane + 64] = d1 * rs * p.v_norm_g[g * 128 + lane + 64] + p.v_norm_b[g * 128 + lane + 64];
        }
        for (int i = tid; i < 128 * 128; i += 512) wl[i] = bf2f(WSP[g * 16384 + i]);
        __syncthreads();
        const int c = tid & 127, iq = tid >> 7;
        float acc[32];
#pragma unroll
        for (int ii = 0; ii < 32; ++ii) acc[ii] = 0.f;
        for (int j4 = 0; j4 < 128; j4 += 4) {
            const float v0 = vn[(j4 + 0) * 128 + c], v1 = vn[(j4 + 1) * 128 + c], v2 = vn[(j4 + 2) * 128 + c], v3 = vn[(j4 + 3) * 128 + c];
#pragma unroll
            for (int ii = 0; ii < 32; ++ii) { const f32x4 w = *(const LAS f32x4*)(wl + (32 * iq + ii) * 128 + j4); acc[ii] += w.x * v0 + w.y * v1 + w.z * v2 + w.w * v3; }
        }
#pragma unroll
        for (int ii = 0; ii < 32; ++ii) {
            const int i = 32 * iq + ii; const size_t tok = tok0 + i;
            const float z = acc[ii] + p.b_sp[g * 128 + i];
            const float uu = bf2f(PR[tok * NPROJ + C_U + g * 128 + c]);
            Y[tok * DM + g * 128 + c] = (bf16)f2bf(uu * z);
        }
    }
}

__device__ __forceinline__ void ph_kvprep(const P& p, LAS unsigned char* lds) {
    const int tid = threadIdx.x, lane = tid & 63, wave = tid >> 6;
    const int gw = blockIdx.x * 8 + wave, NGW = gridDim.x * 8;
    const bf16* PR = (const bf16*)(p.ws + WS_PROJ); const bf16* WU = (const bf16*)(p.ws + WS_WUKV);
    bf16* KB = (bf16*)(p.ws + WS_KB); bf16* VB = (bf16*)(p.ws + WS_VB); bf16* KI = (bf16*)(p.ws + WS_KIDX);
    const f32x2* CS = (const f32x2*)(p.ws + WS_CS);
    LAS float* cn = (LAS float*)(lds + wave * 1024);
    for (int tok = gw; tok < NT; tok += NGW) {
        const u32x2 raw = *(const u32x2*)(PR + (size_t)tok * NPROJ + C_CKV + 4 * lane);
        const float c0 = bflo(raw.x), c1 = bfhi(raw.x), c2 = bflo(raw.y), c3 = bfhi(raw.y);
        const float rs = 1.f / sqrtf(wave_sum(c0 * c0 + c1 * c1 + c2 * c2 + c3 * c3) * (1.f / 256.f) + EPS);
        *(LAS f32x4*)(cn + 4 * lane) = (f32x4){c0 * rs, c1 * rs, c2 * rs, c3 * rs};
        asm volatile("s_waitcnt lgkmcnt(0)" ::: "memory");
        float ok = 0.f, ov = 0.f;
        const bf16* wk = WU + (size_t)lane * 256; const bf16* wv = WU + (size_t)(64 + lane) * 256;
        for (int k = 0; k < 256; k += 8) {
            const u32x4 a = *(const u32x4*)(wk + k), bq = *(const u32x4*)(wv + k);
            const f32x4 x0 = *(const LAS f32x4*)(cn + k), x1 = *(const LAS f32x4*)(cn + k + 4);
            ok += bflo(a.x) * x0.x + bfhi(a.x) * x0.y + bflo(a.y) * x0.z + bfhi(a.y) * x0.w + bflo(a.z) * x1.x + bfhi(a.z) * x1.y + bflo(a.w) * x1.z + bfhi(a.w) * x1.w;
            ov += bflo(bq.x) * x0.x + bfhi(bq.x) * x0.y + bflo(bq.y) * x0.z + bfhi(bq.y) * x0.w + bflo(bq.z) * x1.x + bfhi(bq.z) * x1.y + bflo(bq.w) * x1.z + bfhi(bq.w) * x1.w;
        }
        const f32x2 cs = CS[(size_t)tok * 32 + (lane & 31)];
        {   const float other = __shfl_xor(ok, 32);
            const float x1 = (lane < 32) ? ok : other, x2 = (lane < 32) ? other : ok;
            const float r = (lane < 32) ? (x1 * cs.x - x2 * cs.y) : (x1 * cs.y + x2 * cs.x);
            KB[(size_t)tok * 64 + lane] = (bf16)f2bf(r); }
        VB[(size_t)tok * 64 + lane] = (bf16)f2bf(ov);
        {   const float kr = bf2f(PR[(size_t)tok * NPROJ + C_KI + lane]);
            const float rs2 = 1.f / sqrtf(wave_sum(kr * kr) * (1.f / 64.f) + EPS);
            const float kn = kr * rs2 * p.kidx_norm_g[lane];
            const float other = __shfl_xor(kn, 32);
            const float x1 = (lane < 32) ? kn : other, x2 = (lane < 32) ? other : kn;
            const float r = (lane < 32) ? (x1 * cs.x - x2 * cs.y) : (x1 * cs.y + x2 * cs.x);
            KI[(size_t)tok * 64 + lane] = (bf16)f2bf(r); }
        asm volatile("s_waitcnt lgkmcnt(0)" ::: "memory");
    }
}

__device__ __forceinline__ unsigned sortkey(float f) { const unsigned u = __builtin_bit_cast(unsigned, f); return (u & 0x80000000u) ? ~u : (u | 0x80000000u); }

__device__ __forceinline__ void ph_attn(const P& p, LAS unsigned char* lds) {
    const int tid = threadIdx.x, lane = tid & 63, wave = tid >> 6;
    const int gw = blockIdx.x * 8 + wave, NGW = gridDim.x * 8;
    const bf16* PR = (const bf16*)(p.ws + WS_PROJ);
    const bf16* KB = (const bf16*)(p.ws + WS_KB); const bf16* VB = (const bf16*)(p.ws + WS_VB); const bf16* KI = (const bf16*)(p.ws + WS_KIDX);
    const f32x2* CS = (const f32x2*)(p.ws + WS_CS);
    bf16* Y = (bf16*)(p.ws + WS_Y);
    LAS unsigned char* wl = lds + wave * 19456;
    LAS float* sc = (LAS float*)wl;
    LAS float* qi = (LAS float*)(wl + 16384);
    LAS unsigned short* qb = (LAS unsigned short*)(wl + 16384);
    LAS int* sel = (LAS int*)(wl + 18432);
    for (int qq = gw; qq < NT; qq += NGW) {
        const int tok = qq, b = tok >> 12, i = tok & 4095;
        const int nadm = ((i >> 6) + 1) << 6;
        const size_t kb0 = (size_t)b * SEQ;
        {
            const f32x2 cs = CS[(size_t)tok * 32 + (lane & 31)];
#pragma unroll
            for (int r = 0; r < 4; ++r) { const int h = (lane >> 5) + 2 * r; const bf16* src = PR + (size_t)tok * NPROJ + C_QI + h * 64;
                const float x1 = bf2f(src[lane & 31]), x2 = bf2f(src[32 + (lane & 31)]);
                qi[h * 64 + (lane & 31)] = x1 * cs.x - x2 * cs.y; qi[h * 64 + 32 + (lane & 31)] = x1 * cs.y + x2 * cs.x; }
        }
        float wq[8];
#pragma unroll
        for (int h = 0; h < 8; ++h) wq[h] = bf2f(PR[(size_t)tok * NPROJ + C_WI + h]) * 0.04419417382415922f;
        asm volatile("s_waitcnt lgkmcnt(0)" ::: "memory");
#pragma unroll 1
        for (int s = lane; s < nadm; s += 64) {
            const u32x4* kr = (const u32x4*)(KI + (kb0 + s) * 64);
            float kd[64];
#pragma unroll
            for (int c = 0; c < 8; ++c) { const u32x4 w = kr[c]; kd[8 * c + 0] = bflo(w.x); kd[8 * c + 1] = bfhi(w.x); kd[8 * c + 2] = bflo(w.y); kd[8 * c + 3] = bfhi(w.y); kd[8 * c + 4] = bflo(w.z); kd[8 * c + 5] = bfhi(w.z); kd[8 * c + 6] = bflo(w.w); kd[8 * c + 7] = bfhi(w.w); }
            float score = 0.f;
#pragma unroll
            for (int h = 0; h < 8; ++h) { float d = 0.f;
#pragma unroll
                for (int c = 0; c < 16; ++c) { const f32x4 q4 = *(const LAS f32x4*)(qi + h * 64 + 4 * c); d += q4.x * kd[4 * c] + q4.y * kd[4 * c + 1] + q4.z * kd[4 * c + 2] + q4.w * kd[4 * c + 3]; }
                score += wq[h] * fmaxf(d, 0.f); }
            if (score == 0.f) score = 0.f;
            sc[s] = __builtin_bit_cast(float, sortkey(score));
        }
        asm volatile("s_waitcnt lgkmcnt(0)" ::: "memory");
        int nvalid;
        if (nadm <= 256) { for (int s = lane; s < nadm; s += 64) sel[s] = s; nvalid = nadm; }
        else {
            unsigned prefix = 0u;
            for (int bit = 31; bit >= 0; --bit) {
                const unsigned cand = prefix | (1u << bit); int cnt = 0;
                for (int s = lane; s < nadm; s += 64) cnt += (__builtin_bit_cast(unsigned, sc[s]) >= cand) ? 1 : 0;
#pragma unroll
                for (int o = 1; o < 64; o <<= 1) cnt += __shfl_xor(cnt, o);
                if (cnt >= 256) prefix = cand;
            }
            int cgt = 0;
            for (int s = lane; s < nadm; s += 64) cgt += (__builtin_bit_cast(unsigned, sc[s]) > prefix) ? 1 : 0;
#pragma unroll
            for (int o = 1; o < 64; o <<= 1) cgt += __shfl_xor(cgt, o);
            const int need = 256 - cgt;
            int bgt = 0, beq = 0;
            for (int s0 = 0; s0 < nadm; s0 += 64) {
                const unsigned k = __builtin_bit_cast(unsigned, sc[s0 + lane]);
                const bool gt = k > prefix, eq = k == prefix;
                const unsigned long long mg = __ballot(gt), me = __ballot(eq);
                const unsigned long long lt = (1ull << lane) - 1ull;
                const int pg = bgt + __popcll(mg & lt), pe = beq + __popcll(me & lt);
                if (gt) sel[pg] = s0 + lane;
                if (eq && pe < need) sel[cgt + pe] = s0 + lane;
                bgt += __popcll(mg); beq += __popcll(me);
            }
            nvalid = 256;
        }
        asm volatile("s_waitcnt lgkmcnt(0)" ::: "memory");
        {
            const f32x2 cs = CS[(size_t)tok * 32 + (lane & 31)];
#pragma unroll
            for (int r = 0; r < 8; ++r) { const int h = (lane >> 5) + 2 * r; const bf16* src = PR + (size_t)tok * NPROJ + C_Q + h * 64;
                const float x1 = bf2f(src[lane & 31]), x2 = bf2f(src[32 + (lane & 31)]);
                qb[h * 64 + (lane & 31)] = (unsigned short)f2bf(x1 * cs.x - x2 * cs.y); qb[h * 64 + 32 + (lane & 31)] = (unsigned short)f2bf(x1 * cs.y + x2 * cs.x); }
        }
        asm volatile("s_waitcnt lgkmcnt(0)" ::: "memory");
#pragma unroll 1
        for (int r = 0; r < 4; ++r) {
            const int j = lane + 64 * r; const bool valid = j < nvalid; const int idx = valid ? sel[j] : 0;
            const u32x4* kr = (const u32x4*)(KB + (kb0 + idx) * 64);
            float kd[64];
#pragma unroll
            for (int c = 0; c < 8; ++c) { const u32x4 w = kr[c]; kd[8 * c + 0] = bflo(w.x); kd[8 * c + 1] = bfhi(w.x); kd[8 * c + 2] = bflo(w.y); kd[8 * c + 3] = bfhi(w.y); kd[8 * c + 4] = bflo(w.z); kd[8 * c + 5] = bfhi(w.z); kd[8 * c + 6] = bflo(w.w); kd[8 * c + 7] = bfhi(w.w); }
#pragma unroll 2
            for (int h = 0; h < 16; ++h) { float d = 0.f;
#pragma unroll
                for (int c = 0; c < 8; ++c) { const u32x4 w = *(const LAS u32x4*)(qb + h * 64 + 8 * c);
                    d += bflo(w.x) * kd[8 * c] + bfhi(w.x) * kd[8 * c + 1] + bflo(w.y) * kd[8 * c + 2] + bfhi(w.y) * kd[8 * c + 3] + bflo(w.z) * kd[8 * c + 4] + bfhi(w.z) * kd[8 * c + 5] + bflo(w.w) * kd[8 * c + 6] + bfhi(w.w) * kd[8 * c + 7]; }
                sc[h * 256 + j] = valid ? d * 0.125f : -INFINITY; }
        }
        asm volatile("s_waitcnt lgkmcnt(0)" ::: "memory");
#pragma unroll 1
        for (int h = 0; h < 16; ++h) {
            float v0 = sc[h * 256 + lane], v1 = sc[h * 256 + 64 + lane], v2 = sc[h * 256 + 128 + lane], v3 = sc[h * 256 + 192 + lane];
            const float mx = wave_max(fmaxf(fmaxf(v0, v1), fmaxf(v2, v3)));
            v0 = __expf(v0 - mx); v1 = __expf(v1 - mx); v2 = __expf(v2 - mx); v3 = __expf(v3 - mx);
            const float inv = 1.f / wave_sum(v0 + v1 + v2 + v3);
            sc[h * 256 + lane] = v0 * inv; sc[h * 256 + 64 + lane] = v1 * inv; sc[h * 256 + 128 + lane] = v2 * inv; sc[h * 256 + 192 + lane] = v3 * inv;
        }
        asm volatile("s_waitcnt lgkmcnt(0)" ::: "memory");
        float acc[16];
#pragma unroll
        for (int h = 0; h < 16; ++h) acc[h] = 0.f;
#pragma unroll 2
        for (int j = 0; j < nvalid; ++j) {
            const int idx = sel[j];
            const float v = bf2f(VB[(kb0 + idx) * 64 + lane]);
#pragma unroll
            for (int h = 0; h < 16; ++h) acc[h] += sc[h * 256 + j] * v;
        }
#pragma unroll
        for (int h = 0; h < 16; ++h) Y[(size_t)tok * DM + 1024 + h * 64 + lane] = (bf16)f2bf(acc[h]);
        asm volatile("s_waitcnt lgkmcnt(0)" ::: "memory");
    }
}

__device__ __forceinline__ void ph_ynorm(const P& p) {
    const int tid = threadIdx.x, lane = tid & 63, wave = tid >> 6;
    const int gw = blockIdx.x * 8 + wave, NGW = gridDim.x * 8;
    bf16* Y = (bf16*)(p.ws + WS_Y);
    for (int m = gw; m < NT; m += NGW) {
#pragma unroll
        for (int half = 0; half < 2; ++half) {
            u32x4* r = (u32x4*)(Y + (size_t)m * DM + half * 1024) + lane;
            u32x4 a = r[0], bq = r[64];
            float f[16] = {bflo(a.x), bfhi(a.x), bflo(a.y), bfhi(a.y), bflo(a.z), bfhi(a.z), bflo(a.w), bfhi(a.w), bflo(bq.x), bfhi(bq.x), bflo(bq.y), bfhi(bq.y), bflo(bq.z), bfhi(bq.z), bflo(bq.w), bfhi(bq.w)};
            float ss = 0.f;
#pragma unroll
            for (int k = 0; k < 16; ++k) ss += f[k] * f[k];
            const float rs = 1.f / sqrtf(wave_sum(ss) * (1.f / 1024.f) + EPS);
            a.x = pk2(f[0] * rs, f[1] * rs); a.y = pk2(f[2] * rs, f[3] * rs); a.z = pk2(f[4] * rs, f[5] * rs); a.w = pk2(f[6] * rs, f[7] * rs);
            bq.x = pk2(f[8] * rs, f[9] * rs); bq.y = pk2(f[10] * rs, f[11] * rs); bq.z = pk2(f[12] * rs, f[13] * rs); bq.w = pk2(f[14] * rs, f[15] * rs);
            r[0] = a; r[64] = bq;
        }
    }
}

__device__ __forceinline__ void ph_outproj(const P& p) {
    const int tid = threadIdx.x, lane = tid & 63, wave = tid >> 6, fr = lane & 15, fq = lane >> 4;
    const int gw = blockIdx.x * 8 + wave, NGW = gridDim.x * 8;
    const bf16* Y = (const bf16*)(p.ws + WS_Y); const bf16* W = (const bf16*)(p.ws + WS_WOUT); const float* mod = (const float*)(p.ws + WS_MOD);
    for (int u = gw; u < (NT / 64) * 32; u += NGW) {
        const int mt = u / 32, nt = u % 32;
        const bf16* arow[4]; const bf16* brow[4];
#pragma unroll
        for (int i = 0; i < 4; ++i) { arow[i] = Y + (size_t)(64 * mt + 16 * i + fr) * DM + 8 * fq; brow[i] = W + (size_t)(64 * nt + 16 * i + fr) * DM + 8 * fq; }
        f32x4 acc[4][4];
#pragma unroll
        for (int a = 0; a < 4; ++a)
#pragma unroll
            for (int b = 0; b < 4; ++b) acc[a][b] = (f32x4){0.f, 0.f, 0.f, 0.f};
        SG_LOOP(DM, arow, brow, acc)
#pragma unroll
        for (int mi = 0; mi < 4; ++mi)
#pragma unroll
            for (int ni = 0; ni < 4; ++ni) {
                const int row = 64 * mt + 16 * mi + fr, col = 64 * nt + 16 * ni + 4 * fq, b = row >> 12;
                const f32x4 xv = *(const f32x4*)(p.x + (size_t)row * DM + col), g = *(const f32x4*)(mod + b * 12288 + 2 * 2048 + col);
                *(f32x4*)(p.out + (size_t)row * DM + col) = xv + g * acc[mi][ni];
            }
    }
}

__device__ __forceinline__ void ph_route(const P& p, LAS unsigned char* lds) {
    const int tid = threadIdx.x, lane = tid & 63, wave = tid >> 6;
    LAS float* hl = (LAS float*)(lds + wave * 8192);
    const int gw = blockIdx.x * 8 + wave, NGW = gridDim.x * 8;
    const float* mod = (const float*)(p.ws + WS_MOD);
    bf16* H = (bf16*)(p.ws + WS_H);
    unsigned* cnt = (unsigned*)(p.ws + WS_CTL) + CW_CNT;
    int* list = (int*)(p.ws + WS_LIST); u32x4* tokinfo = (u32x4*)(p.ws + WS_TOK);
    for (int m = gw; m < NT; m += NGW) {
        const int b = m >> 12;
        const f32x4* xr = (const f32x4*)(p.out + (size_t)m * DM) + lane;
        f32x4 v[8]; float ss = 0.f;
#pragma unroll
        for (int j = 0; j < 8; ++j) { v[j] = xr[64 * j]; ss += v[j].x * v[j].x + v[j].y * v[j].y + v[j].z * v[j].z + v[j].w * v[j].w; }
        const float rstd = 1.f / sqrtf(wave_sum(ss) * (1.f / DM) + EPS);
        u32x2* o = (u32x2*)(H + (size_t)m * DM) + lane;
        float lg[36];
#pragma unroll
        for (int q = 0; q < 36; ++q) lg[q] = 0.f;
#pragma unroll
        for (int j = 0; j < 8; ++j) {
            const int col = 4 * lane + 256 * j;
            const f32x4 g = *(const f32x4*)(p.norm2_g + col), sh = *(const f32x4*)(mod + b * 12288 + 3 * 2048 + col), sc = *(const f32x4*)(mod + b * 12288 + 4 * 2048 + col);
            const f32x4 h = v[j] * rstd * g * (sc + 1.f) + sh;
            o[64 * j] = (u32x2){pk2(h.x, h.y), pk2(h.z, h.w)};
            *(LAS f32x4*)(hl + col) = h;
        }
        asm volatile("s_waitcnt lgkmcnt(0)" ::: "memory");
#pragma unroll 2
        for (int it = 0; it < 32; ++it) {
            const int k = it * 64 + lane; const float hv = hl[k];
            const f32x4 wg = *(const f32x4*)(p.w_group + (size_t)k * 4);
            lg[0] += hv * wg.x; lg[1] += hv * wg.y; lg[2] += hv * wg.z; lg[3] += hv * wg.w;
#pragma unroll
            for (int q = 0; q < 8; ++q) { const f32x4 we = *(const f32x4*)(p.w_expert + (size_t)k * 32 + 4 * q);
                lg[4 + 4 * q] += hv * we.x; lg[5 + 4 * q] += hv * we.y; lg[6 + 4 * q] += hv * we.z; lg[7 + 4 * q] += hv * we.w; }
        }
        asm volatile("s_waitcnt lgkmcnt(0)" ::: "memory");
#pragma unroll
        for (int q = 0; q < 36; ++q) lg[q] = wave_sum(lg[q]);
        float gl[4];
#pragma unroll
        for (int q = 0; q < 4; ++q) gl[q] = lg[q] + p.b_group[q];
        int gi = 0; float gm = gl[0];
#pragma unroll
        for (int q = 1; q < 4; ++q) if (gl[q] > gm) { gm = gl[q]; gi = q; }
        float gs = 0.f;
#pragma unroll
        for (int q = 0; q < 4; ++q) gs += expf(gl[q] - gm);
        const float gp = 1.f / gs;
        float el[8];
#pragma unroll
        for (int q = 0; q < 8; ++q) { el[q] = 0.f;
#pragma unroll
            for (int gg = 0; gg < 4; ++gg) if (gg == gi) el[q] = lg[4 + gg * 8 + q] + p.b_expert[gg * 8 + q]; }
        int i1 = 0; float m1 = el[0];
#pragma unroll
        for (int q = 1; q < 8; ++q) if (el[q] > m1) { m1 = el[q]; i1 = q; }
        int i2 = -1; float m2 = -INFINITY;
#pragma unroll
        for (int q = 0; q < 8; ++q) if (q != i1 && el[q] > m2) { m2 = el[q]; i2 = q; }
        const float r2 = expf(m2 - m1);
        const float w0 = gp / (1.f + r2), w1 = gp * r2 / (1.f + r2);
        const int e0 = gi * 8 + i1, e1 = gi * 8 + i2;
        if (lane == 0) {
            const unsigned p0 = atomicAdd(&cnt[e0], 1u), p1 = atomicAdd(&cnt[e1], 1u);
            list[(size_t)e0 * NT + p0] = m; list[(size_t)e1 * NT + p1] = m;
            tokinfo[m] = (u32x4){((unsigned)e0 << 16) | p0, ((unsigned)e1 << 16) | p1, __builtin_bit_cast(unsigned, w0), __builtin_bit_cast(unsigned, w1)};
        }
    }
}

__device__ __forceinline__ void ph_moe1(const P& p) {
    const int tid = threadIdx.x, lane = tid & 63, wave = tid >> 6, fr = lane & 15, fq = lane >> 4;
    const int gw = blockIdx.x * 8 + wave, NGW = gridDim.x * 8;
    const unsigned* cnt = (const unsigned*)(p.ws + WS_CTL) + CW_CNT;
    const int* list = (const int*)(p.ws + WS_LIST);
    const bf16* H = (const bf16*)(p.ws + WS_H); const bf16* W = (const bf16*)(p.ws + WS_W13); bf16* ACT = (bf16*)(p.ws + WS_ACT);
    int ntot = 0;
    for (int e = 0; e < NE; ++e) ntot += ((int)cnt[e] + 63) >> 6;
    for (int u = gw; u < ntot * 16; u += NGW) {
        const int gt = u >> 4, nt = u & 15;
        int e = 0, tp = 0, eb = 0;
        for (; e < NE; ++e) { const int c = (int)cnt[e]; const int nte = (c + 63) >> 6; if (gt < tp + nte) break; tp += nte; eb += (c + 255) & ~255; }
        const int c = (int)cnt[e], mt = gt - tp;
        const bf16* arow[4]; const bf16* b1[4]; const bf16* b3[4];
#pragma unroll
        for (int i = 0; i < 4; ++i) {
            int pos = 64 * mt + 16 * i + fr; pos = pos < c ? pos : c - 1;
            const int tok = list[(size_t)e * NT + pos];
            arow[i] = H + (size_t)tok * DM + 8 * fq;
            const int n = 64 * nt + 16 * i + fr;
            b1[i] = W + ((size_t)(e * 8 + (n >> 7)) * 256 + (n & 127)) * DM + 8 * fq; b3[i] = b1[i] + (size_t)128 * DM;
        }
        f32x4 a1[4][4], a3[4][4];
#pragma unroll
        for (int a = 0; a < 4; ++a)
#pragma unroll
            for (int b = 0; b < 4; ++b) { a1[a][b] = (f32x4){0.f, 0.f, 0.f, 0.f}; a3[a][b] = (f32x4){0.f, 0.f, 0.f, 0.f}; }
        for (int k0 = 0; k0 < DM; k0 += 32) {
            bf16x8 af[4], bf1[4], bf3[4];
#pragma unroll
            for (int i = 0; i < 4; ++i) { af[i] = *(const bf16x8*)(arow[i] + k0); bf1[i] = *(const bf16x8*)(b1[i] + k0); bf3[i] = *(const bf16x8*)(b3[i] + k0); }
#pragma unroll
            for (int mi = 0; mi < 4; ++mi)
#pragma unroll
                for (int ni = 0; ni < 4; ++ni) { a1[mi][ni] = __builtin_amdgcn_mfma_f32_16x16x32_bf16(bf1[ni], af[mi], a1[mi][ni], 0, 0, 0); a3[mi][ni] = __builtin_amdgcn_mfma_f32_16x16x32_bf16(bf3[ni], af[mi], a3[mi][ni], 0, 0, 0); }
        }
#pragma unroll
        for (int mi = 0; mi < 4; ++mi) {
            const int pos = 64 * mt + 16 * mi + fr;
            if (pos < c) {
#pragma unroll
                for (int ni = 0; ni < 4; ++ni) {
                    const f32x4 a = a1[mi][ni], g = a3[mi][ni];
                    *(u32x2*)(ACT + (size_t)(eb + pos) * DE + 64 * nt + 16 * ni + 4 * fq) = (u32x2){pk2(silu_f(a.x) * g.x, silu_f(a.y) * g.y), pk2(silu_f(a.z) * g.z, silu_f(a.w) * g.w)};
                }
            }
        }
    }
}

__device__ __forceinline__ void ph_moe2(const P& p) {
    const int tid = threadIdx.x, lane = tid & 63, wave = tid >> 6, fr = lane & 15, fq = lane >> 4;
    const int gw = blockIdx.x * 8 + wave, NGW = gridDim.x * 8;
    const unsigned* cnt = (const unsigned*)(p.ws + WS_CTL) + CW_CNT;
    const bf16* ACT = (const bf16*)(p.ws + WS_ACT); const bf16* W = (const bf16*)(p.ws + WS_W2); bf16* YM = (bf16*)(p.ws + WS_YMOE);
    int ntot = 0;
    for (int e = 0; e < NE; ++e) ntot += ((int)cnt[e] + 63) >> 6;
    for (int u = gw; u < ntot * 32; u += NGW) {
        const int gt = u >> 5, nt = u & 31;
        int e = 0, tp = 0, eb = 0;
        for (; e < NE; ++e) { const int c = (int)cnt[e]; const int nte = (c + 63) >> 6; if (gt < tp + nte) break; tp += nte; eb += (c + 255) & ~255; }
        const int c = (int)cnt[e], mt = gt - tp;
        const bf16* arow[4]; const bf16* brow[4];
#pragma unroll
        for (int i = 0; i < 4; ++i) {
            int pos = 64 * mt + 16 * i + fr; pos = pos < c ? pos : c - 1;
            arow[i] = ACT + (size_t)(eb + pos) * DE + 8 * fq;
            brow[i] = W + ((size_t)e * DM + 64 * nt + 16 * i + fr) * DE + 8 * fq;
        }
        f32x4 acc[4][4];
#pragma unroll
        for (int a = 0; a < 4; ++a)
#pragma unroll
            for (int b = 0; b < 4; ++b) acc[a][b] = (f32x4){0.f, 0.f, 0.f, 0.f};
        SG_LOOP(DE, arow, brow, acc)
#pragma unroll
        for (int mi = 0; mi < 4; ++mi) {
            const int pos = 64 * mt + 16 * mi + fr;
            if (pos < c) {
#pragma unroll
                for (int ni = 0; ni < 4; ++ni) { const f32x4 a = acc[mi][ni];
                    *(u32x2*)(YM + (size_t)(eb + pos) * DM + 64 * nt + 16 * ni + 4 * fq) = (u32x2){pk2(a.x, a.y), pk2(a.z, a.w)}; }
            }
        }
    }
}

__device__ __forceinline__ void ph_final(const P& p) {
    const int tid = threadIdx.x, lane = tid & 63, wave = tid >> 6;
    const int gw = blockIdx.x * 8 + wave, NGW = gridDim.x * 8;
    const unsigned* cnt = (const unsigned*)(p.ws + WS_CTL) + CW_CNT;
    const u32x4* tokinfo = (const u32x4*)(p.ws + WS_TOK); const bf16* YM = (const bf16*)(p.ws + WS_YMOE); const float* mod = (const float*)(p.ws + WS_MOD);
    int myb = 0;
    { int run = 0; for (int e = 0; e < NE; ++e) { if (lane == e) myb = run; run += ((int)cnt[e] + 255) & ~255; } }
    for (int m = gw; m < NT; m += NGW) {
        const int b = m >> 12;
        const u32x4 ti = tokinfo[m];
        const int e0 = ti.x >> 16, p0 = ti.x & 0xffff, e1 = ti.y >> 16, p1 = ti.y & 0xffff;
        const unsigned w0b = ti.z, w1b = ti.w;
        const float w0 = __uint_as_float(w0b), w1 = __uint_as_float(w1b);
        const size_t r0 = (size_t)(__shfl(myb, e0) + p0), r1 = (size_t)(__shfl(myb, e1) + p1);
        f32x4* xr = (f32x4*)(p.out + (size_t)m * DM) + lane;
        const u32x2* y0 = (const u32x2*)(YM + r0 * DM) + lane; const u32x2* y1 = (const u32x2*)(YM + r1 * DM) + lane;
        f32x4 v[8]; float ss = 0.f;
#pragma unroll
        for (int j = 0; j < 8; ++j) {
            const int col = 4 * lane + 256 * j;
            const f32x4 xv = xr[64 * j]; const u32x2 a = y0[64 * j], c = y1[64 * j];
            const f32x4 g2 = *(const f32x4*)(mod + b * 12288 + 5 * 2048 + col);
            const f32x4 ya = {bflo(a.x), bfhi(a.x), bflo(a.y), bfhi(a.y)}, yb = {bflo(c.x), bfhi(c.x), bflo(c.y), bfhi(c.y)};
            v[j] = xv + g2 * (ya * w0 + yb * w1);
            ss += v[j].x * v[j].x + v[j].y * v[j].y + v[j].z * v[j].z + v[j].w * v[j].w;
        }
        const float rstd = 1.f / sqrtf(wave_sum(ss) * (1.f / DM) + EPS);
#pragma unroll
        for (int j = 0; j < 8; ++j) { const int col = 4 * lane + 256 * j; xr[64 * j] = v[j] * rstd * *(const f32x4*)(p.final_g + col); }
    }
}


__global__ void __launch_bounds__(512, 2) mk_fwd(P p) {
    extern __shared__ __attribute__((aligned(16))) unsigned char lds_raw[];
    LAS unsigned char* lds = (LAS unsigned char*)lds_raw;
    const int lo = p.ph_lo, hi = p.ph_hi;
#ifdef PHSEL
#define IN(k) ((k)==PHSEL && lo <= (k) && (k) < hi)
#else
#define IN(k) (lo <= (k) && (k) < hi)
#endif
    if (IN(0)) ph_prep(p, lds);
    if (IN(1)) ph_h(p);
    if (IN(2)) ph_inproj(p);
    if (IN(3)) { ph_gmlp(p, lds); __syncthreads(); ph_kvprep(p, lds); }
    if (IN(4)) ph_attn(p, lds);
    if (IN(5)) ph_ynorm(p);
    if (IN(6)) ph_outproj(p);
    if (IN(7)) ph_route(p, lds);
    if (IN(8)) ph_moe1(p);
    if (IN(9)) ph_moe2(p);
    if (IN(10)) ph_final(p);
#undef IN
}

extern "C" void kernel_launch(void* const* d_in, const int* in_sizes, int n_in, void* d_out, int out_size, void* d_ws, size_t ws_size, hipStream_t stream) {
    static int grid = 0;
    if (grid == 0) {
        if (n_in != 27 || out_size != NT * DM || ws_size < WS_END) { fprintf(stderr, "kernel_launch: unexpected shapes n_in %d out %d ws %zu\n", n_in, out_size, ws_size); grid = -1; return; }
        int dev = 0, cus = 0;
        if (hipGetDevice(&dev) != hipSuccess || hipDeviceGetAttribute(&cus, hipDeviceAttributeMultiprocessorCount, dev) != hipSuccess) { grid = -1; return; }
        if (hipFuncSetAttribute((const void*)mk_fwd, hipFuncAttributeMaxDynamicSharedMemorySize, LDS_BYTES) != hipSuccess) { fprintf(stderr, "kernel_launch: hipFuncSetAttribute failed\n"); grid = -1; return; }
        grid = cus;
    }
    if (grid < 0) return;
    (void)hipMemsetAsync((char*)d_ws + WS_CTL, 0, CTL_BYTES, stream);
    P p{};
    p.x = (const float*)d_in[0]; p.c = (const float*)d_in[1]; p.pos = (const int*)d_in[2];
    p.w_ada = (const float*)d_in[3]; p.b_ada = (const float*)d_in[4]; p.norm1_g = (const float*)d_in[5]; p.w_in = (const float*)d_in[6];
    p.v_norm_g = (const float*)d_in[7]; p.v_norm_b = (const float*)d_in[8]; p.w_sp = (const float*)d_in[9]; p.b_sp = (const float*)d_in[10];
    p.kv_norm_g = (const float*)d_in[11]; p.w_uk = (const float*)d_in[12]; p.w_uv = (const float*)d_in[13]; p.kidx_norm_g = (const float*)d_in[14];
    p.gnorm_a_g = (const float*)d_in[15]; p.gnorm_b_g = (const float*)d_in[16]; p.w_out = (const float*)d_in[17]; p.norm2_g = (const float*)d_in[18];
    p.w_group = (const float*)d_in[19]; p.b_group = (const float*)d_in[20]; p.w_expert = (const float*)d_in[21]; p.b_expert = (const float*)d_in[22];
    p.w1 = (const float*)d_in[23]; p.w3 = (const float*)d_in[24]; p.w2 = (const float*)d_in[25]; p.final_g = (const float*)d_in[26];
    p.out = (float*)d_out; p.ws = (unsigned char*)d_ws;
    for (int i = 0; i < 32; ++i) p.freqs[i] = (float)pow(10000.0, -(double)i / 32.0);
    for (int ph = 0; ph < 11; ++ph) {
        p.ph_lo = ph; p.ph_hi = ph + 1;
        hipLaunchKernelGGL(mk_fwd, dim3(grid), dim3(512), LDS_BYTES, stream, p);
    }
}
```

```cpp
#include <hip/hip_runtime.h>
#include <cstdio>
#include <cstdint>
#include <cmath>

#define LAS __attribute__((address_space(3)))
typedef unsigned short bf16;
typedef short bf16x8 __attribute__((ext_vector_type(8)));
typedef float f32x4 __attribute__((ext_vector_type(4)));
typedef float f32x2 __attribute__((ext_vector_type(2)));
typedef unsigned u32x4 __attribute__((ext_vector_type(4)));
typedef unsigned u32x2 __attribute__((ext_vector_type(2)));

constexpr int NB = 8, SEQ = 4096, DM = 2048, NT = NB * SEQ;
constexpr int NPROJ = 4096, INC = 3912;
constexpr int C_U = 0, C_V = 1024, C_Q = 2048, C_CKV = 3072, C_QI = 3328, C_KI = 3840, C_WI = 3904;
constexpr int NE = 32, DE = 1024;
constexpr int SLOT_ROWS = 65536 + 32 * 256;
constexpr float EPS = 1e-6f;
constexpr int NPH = 12;

constexpr size_t MiB = 1u << 20;
constexpr size_t WS_CTL = 0, CTL_BYTES = 1 * MiB;
constexpr size_t WS_MOD = 1 * MiB;
constexpr size_t WS_CS = 2 * MiB;
constexpr size_t WS_WIN = 10 * MiB;
constexpr size_t WS_WOUT = 26 * MiB;
constexpr size_t WS_WSP = 34 * MiB;
constexpr size_t WS_WUKV = 34 * MiB + 256 * 1024;
constexpr size_t WS_WR = 34 * MiB + 512 * 1024;
constexpr size_t WS_KB = 35 * MiB, WS_VB = 39 * MiB, WS_KIDX = 43 * MiB;
constexpr size_t WS_SSQ = 47 * MiB;
constexpr size_t WS_LIST = 48 * MiB;
constexpr size_t WS_TOK = 52 * MiB;
constexpr size_t WS_W13 = 56 * MiB;
constexpr size_t WS_W2 = 312 * MiB;
constexpr size_t WS_PROJ = 440 * MiB;
constexpr size_t WS_H = 696 * MiB;
constexpr size_t WS_Y = 824 * MiB;
constexpr size_t WS_ACT = WS_PROJ;
constexpr size_t WS_YMOE = 584 * MiB;
constexpr size_t WS_SCR = 952 * MiB;
constexpr size_t WS_SCR2 = 248 * MiB;
constexpr size_t WS_H8 = 184 * MiB;
constexpr size_t WS_WIN8 = 376 * MiB;
constexpr size_t WS_X1 = 1016 * MiB;
constexpr size_t WS_Y8 = WS_H;
constexpr size_t WS_END = 1144 * MiB;
constexpr int CW_BAR = 4096, CW_CNT = 16384;

constexpr int LDS_BYTES = 163840 - 512;
constexpr int LDS_MISC = LDS_BYTES - 64;

struct P {
    const float *x, *c; const int* pos;
    const float *w_ada, *b_ada, *norm1_g, *w_in, *v_norm_g, *v_norm_b, *w_sp, *b_sp, *kv_norm_g, *w_uk, *w_uv, *kidx_norm_g, *gnorm_a_g, *gnorm_b_g, *w_out, *norm2_g,
        *w_group, *b_group, *w_expert, *b_expert, *w1, *w3, *w2, *final_g;
    float* out; unsigned char* ws;
    int ph_lo, ph_hi;
    float freqs[32];
};

__device__ __forceinline__ int otid() { int t = threadIdx.x; asm volatile("" : "+v"(t)); return t; }
__device__ __forceinline__ unsigned f2bf(float f) { unsigned u = __builtin_bit_cast(unsigned, f); return (u + 0x7fffu + ((u >> 16) & 1u)) >> 16; }
typedef __bf16 hwbf16x2 __attribute__((ext_vector_type(2)));
typedef float hwf32x2 __attribute__((ext_vector_type(2)));
__device__ __forceinline__ unsigned pk2(float lo, float hi) { const hwf32x2 v = {lo, hi}; return __builtin_bit_cast(unsigned, __builtin_convertvector(v, hwbf16x2)); }
__device__ __forceinline__ float bflo(unsigned w) { return __builtin_bit_cast(float, w << 16); }
__device__ __forceinline__ float bfhi(unsigned w) { return __builtin_bit_cast(float, w & 0xffff0000u); }
__device__ __forceinline__ float bf2f(bf16 b) { return __builtin_bit_cast(float, ((unsigned)b) << 16); }
template <int CTRL> __device__ __forceinline__ float dpp_f(float v) { return __int_as_float(__builtin_amdgcn_update_dpp(0, __float_as_int(v), CTRL, 0xf, 0xf, false)); }
__device__ __forceinline__ float row16_sum(float v) { v += dpp_f<0x128>(v); v += dpp_f<0x124>(v); v += dpp_f<0x122>(v); v += dpp_f<0x121>(v); return v; }
__device__ __forceinline__ float row16_max(float v) { v = fmaxf(v, dpp_f<0x128>(v)); v = fmaxf(v, dpp_f<0x124>(v)); v = fmaxf(v, dpp_f<0x122>(v)); v = fmaxf(v, dpp_f<0x121>(v)); return v; }
__device__ __forceinline__ float wave_sum(float v) { v = row16_sum(v); v += __shfl_xor(v, 16); v += __shfl_xor(v, 32); return v; }
__device__ __forceinline__ float wave_max(float v) { v = row16_max(v); v = fmaxf(v, __shfl_xor(v, 16)); v = fmaxf(v, __shfl_xor(v, 32)); return v; }
__device__ __forceinline__ float gelu_tanh(float x) {
    const float y2 = x * (1.5957691216057308f + 0.07135481627260025f * x * x);
    const float e = __expf(y2);
    return x - x * __builtin_amdgcn_rcpf(1.f + e);
}
__device__ __forceinline__ float relu_i(float x) { const int b = __float_as_int(x); return __int_as_float(b > 0 ? b : 0); }
__device__ __forceinline__ float silu_f(float x) { return x * __builtin_amdgcn_rcpf(1.f + __expf(-x)); }
__device__ __forceinline__ void sincos_acc(float angf, float& s, float& c) {
    const double x = (double)angf;
    const double kd = rint(x * 0.6366197723675814);
    double r = fma(-kd, 1.5707963267948966, x);
    r = fma(-kd, 6.123233995736766e-17, r);
    const int q = (int)((long long)kd & 3);
    const double r2 = r * r;
    const double sp = r * (1.0 + r2 * (-1.0 / 6 + r2 * (1.0 / 120 + r2 * (-1.0 / 5040 + r2 * (1.0 / 362880 + r2 * (-1.0 / 39916800 + r2 * (1.0 / 6227020800.0)))))));
    const double cp = 1.0 + r2 * (-0.5 + r2 * (1.0 / 24 + r2 * (-1.0 / 720 + r2 * (1.0 / 40320 + r2 * (-1.0 / 3628800 + r2 * (1.0 / 479001600 + r2 * (-1.0 / 87178291200.0)))))));
    double ss, cc;
    if (q == 0) { ss = sp; cc = cp; } else if (q == 1) { ss = cp; cc = -sp; } else if (q == 2) { ss = -sp; cc = -cp; } else { ss = -cp; cc = sp; }
    s = (float)ss; c = (float)cc;
}


#define XB_TMO      128
#define XB_XCNT(j)  (256  + 64 * (j))
#define XB_XSUB(j)  (1280 + 64 * (j))
#define XB_XGEN(j)  (2304 + 64 * (j))
#define XB_TOP      3328
#define XB_TOPGEN   3392
#define XCD_BAR_WORDS 3456
#define XB_SPIN_CAP (1u << 18)
__device__ __forceinline__ unsigned xb_ld(unsigned* p)              { return __hip_atomic_load(p, __ATOMIC_RELAXED, __HIP_MEMORY_SCOPE_AGENT); }
__device__ __forceinline__ unsigned xb_add(unsigned* p, unsigned v) { return __hip_atomic_fetch_add(p, v, __ATOMIC_RELAXED, __HIP_MEMORY_SCOPE_AGENT); }
__device__ __forceinline__ unsigned xb_xcc_id() { return (unsigned)__builtin_amdgcn_s_getreg((3 << 11) | 20) & 0xFu; }
#define XB_SPIN(cond, bar) do { unsigned _sp = 0; while (cond) { __builtin_amdgcn_s_sleep(1); \
    if ((++_sp & 255u) == 0u) { if (xb_ld(&(bar)[XB_TMO])) break; if (_sp > XB_SPIN_CAP) { atomicAdd(&(bar)[XB_TMO], 1u); break; } } } } while (0)
struct XcdBarrier { unsigned* bar; unsigned x; volatile LAS unsigned* st; };
__device__ __forceinline__ XcdBarrier xcd_barrier_post(unsigned* bar, volatile LAS unsigned* st) {
    XcdBarrier b; b.bar = bar; b.x = xb_xcc_id(); b.st = st;
    if (threadIdx.x == 0) (void)xb_add(&bar[XB_XCNT(b.x)], 1u);
    return b;
}
__device__ __forceinline__ void xcd_barrier_complete(unsigned* bar, unsigned x, unsigned& nloc, unsigned& nx) {
    const unsigned G = gridDim.x * gridDim.y * gridDim.z;
    unsigned sum, cnt, mine, sp = 0u;
    for (;;) {
        sum = 0u; cnt = 0u; mine = 0u;
#pragma unroll
        for (unsigned j = 0; j < 16; ++j) { const unsigned c = xb_ld(&bar[XB_XCNT(j)]); sum += c; cnt += (c > 0u) ? 1u : 0u; mine = (j == x) ? c : mine; }
        if (sum == G) break;
        __builtin_amdgcn_s_sleep(1);
        if ((++sp & 255u) == 0u) { if (xb_ld(&bar[XB_TMO])) break; if (sp > XB_SPIN_CAP) { atomicAdd(&bar[XB_TMO], 1u); break; } }
    }
    nloc = mine > 0u ? mine : 1u; nx = cnt > 0u ? cnt : 1u;
}
__device__ __forceinline__ void xcd_barrier(const XcdBarrier& b) {
    asm volatile("s_waitcnt vmcnt(0)" ::: "memory");
    __syncthreads();
    if (threadIdx.x == 0) {
        unsigned* bar = b.bar;
        __builtin_amdgcn_s_waitcnt(0);
        unsigned nloc = b.st[0], nx = b.st[1];
        if (nloc == 0u) { xcd_barrier_complete(bar, b.x, nloc, nx); b.st[0] = nloc; b.st[1] = nx; }
        const unsigned old = xb_add(&bar[XB_XSUB(b.x)], 1u);
        const unsigned gen = old / nloc;
        if (old + 1u == (gen + 1u) * nloc) {
            __builtin_amdgcn_fence(__ATOMIC_RELEASE, "agent");
            asm volatile("s_waitcnt vmcnt(0)" ::: "memory");
            const unsigned og = xb_add(&bar[XB_TOP], 1u);
            const unsigned tg = og / nx;
            if (og + 1u == (tg + 1u) * nx) xb_add(&bar[XB_TOPGEN], 1u);
            else XB_SPIN(xb_ld(&bar[XB_TOPGEN]) == tg, bar);
            xb_add(&bar[XB_XGEN(b.x)], 1u);
            __builtin_amdgcn_fence(__ATOMIC_ACQUIRE, "agent");
            asm volatile("s_waitcnt vmcnt(0)" ::: "memory");
        } else {
            XB_SPIN(xb_ld(&bar[XB_XGEN(b.x)]) == gen, bar);
            __builtin_amdgcn_fence(__ATOMIC_ACQUIRE, "agent");
            asm volatile("s_waitcnt vmcnt(0)" ::: "memory");
        }
    }
    __syncthreads();
}

__device__ __forceinline__ void tr_item(const float* src, int ld, int nvalid, int k0, int n0, bf16* dst_n0, int ldd, const float* kscale, LAS float* scr, int lane) {
    float lv[32];
#pragma unroll
    for (int i = 0; i < 32; ++i) { const int kk = 2 * i + (lane >> 5), n = n0 + (lane & 31); lv[i] = (n < nvalid) ? __builtin_nontemporal_load(src + (size_t)(k0 + kk) * ld + n) : 0.f; }
#pragma unroll
    for (int i = 0; i < 32; ++i) {
        const int kk = 2 * i + (lane >> 5);
        float v = lv[i];
        if (kscale) v *= kscale[k0 + kk];
        scr[kk * 33 + (lane & 31)] = v;
    }
    asm volatile("s_waitcnt lgkmcnt(0)" ::: "memory");
    const int c = lane & 7;
#pragma unroll
    for (int j = 0; j < 4; ++j) {
        const int n = (lane >> 3) + 8 * j; const LAS float* s = scr + (8 * c) * 33 + n;
        u32x4 o; o.x = pk2(s[0 * 33], s[1 * 33]); o.y = pk2(s[2 * 33], s[3 * 33]); o.z = pk2(s[4 * 33], s[5 * 33]); o.w = pk2(s[6 * 33], s[7 * 33]);
        *(u32x4*)(dst_n0 + (size_t)n * ldd + k0 + 8 * c) = o;
    }
    asm volatile("s_waitcnt lgkmcnt(0)" ::: "memory");
}

__device__ __forceinline__ void tr_item_fp8(const float* src, int ld, int k0, int n0, unsigned char* dst_n0, int ldd, float sc, LAS float* scr, int lane, const float* kscale = nullptr) {
    f32x4 ld4[8];
#pragma unroll
    for (int i = 0; i < 8; ++i) ld4[i] = __builtin_nontemporal_load((const f32x4*)(src + (size_t)(k0 + 8 * i + (lane >> 3)) * ld + n0 + 4 * (lane & 7)));
#pragma unroll
    for (int i = 0; i < 8; ++i) { const int kk = 8 * i + (lane >> 3); float m = sc; if (kscale) m *= kscale[k0 + kk]; LAS float* q = scr + kk * 33 + 4 * (lane & 7);
        q[0] = ld4[i].x * m; q[1] = ld4[i].y * m; q[2] = ld4[i].z * m; q[3] = ld4[i].w * m; }
    asm volatile("s_waitcnt lgkmcnt(0)" ::: "memory");
    const int c = lane & 3;
#pragma unroll
    for (int j = 0; j < 2; ++j) {
        const int n = (lane >> 2) + 16 * j; const LAS float* q = scr + (16 * c) * 33 + n;
        u32x4 o; int w;
        w = __builtin_amdgcn_cvt_pk_fp8_f32(q[0 * 33], q[1 * 33], 0, false); w = __builtin_amdgcn_cvt_pk_fp8_f32(q[2 * 33], q[3 * 33], w, true); o.x = (unsigned)w;
        w = __builtin_amdgcn_cvt_pk_fp8_f32(q[4 * 33], q[5 * 33], 0, false); w = __builtin_amdgcn_cvt_pk_fp8_f32(q[6 * 33], q[7 * 33], w, true); o.y = (unsigned)w;
        w = __builtin_amdgcn_cvt_pk_fp8_f32(q[8 * 33], q[9 * 33], 0, false); w = __builtin_amdgcn_cvt_pk_fp8_f32(q[10 * 33], q[11 * 33], w, true); o.z = (unsigned)w;
        w = __builtin_amdgcn_cvt_pk_fp8_f32(q[12 * 33], q[13 * 33], 0, false); w = __builtin_amdgcn_cvt_pk_fp8_f32(q[14 * 33], q[15 * 33], w, true); o.w = (unsigned)w;
        *(u32x4*)(dst_n0 + (size_t)n * ldd + k0 + 16 * c) = o;
    }
    asm volatile("s_waitcnt lgkmcnt(0)" ::: "memory");
}

struct TrPair { f32x4 v[2][8]; };
__device__ __forceinline__ void tr_pair_load(TrPair& t, const float* src, int ld, int k0, int n0, int lane) {
#pragma unroll
    for (int h = 0; h < 2; ++h)
#pragma unroll
        for (int i = 0; i < 8; ++i) { const float* q = src + (size_t)(k0 + 64 * h + 8 * i + (lane >> 3)) * ld + n0 + 4 * (lane & 7);
            asm volatile("global_load_dwordx4 %0, %1, off nt" : "=&v"(t.v[h][i]) : "v"(q) : "memory"); }
}
#define TR_PAIR_WAIT(t, n) asm volatile("s_waitcnt vmcnt(" #n ")" : "+v"(t.v[0][0]), "+v"(t.v[0][1]), "+v"(t.v[0][2]), "+v"(t.v[0][3]), "+v"(t.v[0][4]), "+v"(t.v[0][5]), "+v"(t.v[0][6]), "+v"(t.v[0][7]), \
        "+v"(t.v[1][0]), "+v"(t.v[1][1]), "+v"(t.v[1][2]), "+v"(t.v[1][3]), "+v"(t.v[1][4]), "+v"(t.v[1][5]), "+v"(t.v[1][6]), "+v"(t.v[1][7]) :: "memory")
__device__ __forceinline__ void tr_pair_store(const TrPair& t, int k0, unsigned char* dst_n0, int ldd, float sc, LAS float* scr, int lane) {
#pragma unroll
    for (int h = 0; h < 2; ++h) {
#pragma unroll
        for (int i = 0; i < 8; ++i) { const int kk = 8 * i + (lane >> 3); LAS float* q = scr + kk * 33 + 4 * (lane & 7);
            q[0] = t.v[h][i].x * sc; q[1] = t.v[h][i].y * sc; q[2] = t.v[h][i].z * sc; q[3] = t.v[h][i].w * sc; }
        asm volatile("s_waitcnt lgkmcnt(0)" ::: "memory");
        const int c = lane & 3;
#pragma unroll
        for (int j = 0; j < 2; ++j) {
            const int n = (lane >> 2) + 16 * j; const LAS float* q = scr + (16 * c) * 33 + n;
            u32x4 o; int w;
            w = __builtin_amdgcn_cvt_pk_fp8_f32(q[0 * 33], q[1 * 33], 0, false); w = __builtin_amdgcn_cvt_pk_fp8_f32(q[2 * 33], q[3 * 33], w, true); o.x = (unsigned)w;
            w = __builtin_amdgcn_cvt_pk_fp8_f32(q[4 * 33], q[5 * 33], 0, false); w = __builtin_amdgcn_cvt_pk_fp8_f32(q[6 * 33], q[7 * 33], w, true); o.y = (unsigned)w;
            w = __builtin_amdgcn_cvt_pk_fp8_f32(q[8 * 33], q[9 * 33], 0, false); w = __builtin_amdgcn_cvt_pk_fp8_f32(q[10 * 33], q[11 * 33], w, true); o.z = (unsigned)w;
            w = __builtin_amdgcn_cvt_pk_fp8_f32(q[12 * 33], q[13 * 33], 0, false); w = __builtin_amdgcn_cvt_pk_fp8_f32(q[14 * 33], q[15 * 33], w, true); o.w = (unsigned)w;
            *(u32x4*)(dst_n0 + (size_t)n * ldd + k0 + 64 * h + 16 * c) = o;
        }
        asm volatile("s_waitcnt lgkmcnt(0)" ::: "memory");
    }
}

struct ExpItem { const float* src; unsigned char* dst; int ld, ldd, k0, n0; };
__device__ __forceinline__ ExpItem exp_item(const P& p, int r) {
    constexpr int I_2 = 32 * 512;
    ExpItem it;
    if (r < I_2) { const int e = r / 512, q = r % 512, kb = q / 64, nb = q % 64;
        it.src = p.w2 + (size_t)e * DE * DM; it.ld = DM; it.k0 = 128 * kb; it.n0 = 32 * nb; it.dst = (unsigned char*)(p.ws + WS_W2) + ((size_t)e * DM + 32 * nb) * DE; it.ldd = DE; }
    else { r -= I_2; const int mat = r / 512, q = r % 512, e = mat >> 1, which = mat & 1, kb = q / 32, nb = q % 32; const int n0 = 32 * nb;
        it.src = (which ? p.w3 : p.w1) + (size_t)e * DM * DE; it.ld = DE; it.k0 = 128 * kb; it.n0 = n0;
        it.dst = (unsigned char*)(p.ws + WS_W13) + ((size_t)(e * 8 + n0 / 128) * 256 + (n0 % 128) + which * 128) * DM; it.ldd = DM; }
    return it;
}
constexpr int EXP_NIT = 96 * 512, EXP_CHUNK = 64, EXP_NCHUNK = EXP_NIT / EXP_CHUNK;
constexpr int AT_NA = 32;
__device__ __forceinline__ void exp_convert_range(const P& p, LAS unsigned char* lds, int r0, int r_end, int stride) {
    const int tid = otid(), lane = tid & 63, wave = tid >> 6;
    LAS float* scr = (LAS float*)(lds + wave * 8704);
    TrPair A, B; ExpItem ia, ib;
    int r = r0;
    if (r < r_end) { ia = exp_item(p, r); tr_pair_load(A, ia.src, ia.ld, ia.k0, ia.n0, lane); }
    while (r < r_end) {
        const int r1 = r + stride; const bool m1 = r1 < r_end;
        if (m1) { ib = exp_item(p, r1); tr_pair_load(B, ib.src, ib.ld, ib.k0, ib.n0, lane); TR_PAIR_WAIT(A, 16); } else TR_PAIR_WAIT(A, 0);
        tr_pair_store(A, ia.k0, ia.dst, ia.ldd, 64.f, scr, lane);
        if (!m1) break;
        const int r2 = r1 + stride; const bool m2 = r2 < r_end;
        if (m2) { ia = exp_item(p, r2); tr_pair_load(A, ia.src, ia.ld, ia.k0, ia.n0, lane); TR_PAIR_WAIT(B, 16); } else TR_PAIR_WAIT(B, 0);
        tr_pair_store(B, ib.k0, ib.dst, ib.ldd, 64.f, scr, lane);
        r = r2;
    }
}
__device__ __forceinline__ void ph_convert_chunk(const P& p, LAS unsigned char* lds, int c) {
    __syncthreads();
    exp_convert_range(p, lds, c * EXP_CHUNK + (otid() >> 6), (c + 1) * EXP_CHUNK, 8);
    __syncthreads();
}
__device__ __forceinline__ void ph_prep_experts(const P& p, LAS unsigned char* lds) {
    exp_convert_range(p, lds, 512 * EXP_CHUNK + (int)blockIdx.x * 8 + (otid() >> 6), EXP_NIT, (int)gridDim.x * 8);
}

__device__ __forceinline__ void ph_prep(const P& p, LAS unsigned char* lds) {
    const int tid = otid(), lane = tid & 63, wave = tid >> 6;
    const int gw = blockIdx.x * 8 + wave, NGW = gridDim.x * 8;
    unsigned char* ws = p.ws;
    LAS float* scr = (LAS float*)(lds + wave * 8704);
    constexpr int I_IN = 32 * 128, I_OUT = 32 * 64, I_13 = 0, I_2 = 0, I_UKV = 16;
    constexpr int NIT = I_IN + I_OUT + I_13 + I_2 + I_UKV;
    for (int it = gw; it < NIT; it += NGW) {
        int r = it;
        if (r < I_IN) { const int kb = r / 128, nb = r % 128;
            if (nb < 96) tr_item_fp8(p.w_in, INC, 64 * kb, 32 * nb, (unsigned char*)(ws + WS_WIN8) + (size_t)(32 * nb) * DM, DM, 64.f, scr, lane);
            else tr_item(p.w_in, INC, INC, 64 * kb, 32 * nb, (bf16*)(ws + WS_WIN) + (size_t)(32 * nb) * DM, DM, nullptr, scr, lane);
            continue; }
        r -= I_IN;
        if (r < I_OUT) { const int kb = r / 64, nb = r % 64; const int k0 = 64 * kb;
            tr_item_fp8(p.w_out, DM, k0, 32 * nb, (unsigned char*)(ws + WS_WOUT) + (size_t)(32 * nb) * DM, DM, 64.f, scr, lane, (k0 < 1024) ? p.gnorm_a_g : (p.gnorm_b_g - 1024)); continue; }
        r -= I_OUT;
        if (r < I_13) { const int mat = r / 1024, q = r % 1024, e = mat >> 1, which = mat & 1, kb = q / 32, nb = q % 32; const int n0 = 32 * nb;
            const float* src = (which ? p.w3 : p.w1) + (size_t)e * DM * DE;
            unsigned char* dst = (unsigned char*)(ws + WS_W13) + ((size_t)(e * 8 + n0 / 128) * 256 + (n0 % 128) + which * 128) * DM;
            tr_item_fp8(src, DE, 64 * kb, n0, dst, DM, 64.f, scr, lane);
            continue; }
        r -= I_13;
        if (r < I_2) { const int e = r / 1024, q = r % 1024, kb = q / 64, nb = q % 64;
            tr_item_fp8(p.w2 + (size_t)e * DE * DM, DM, 64 * kb, 32 * nb, (unsigned char*)(ws + WS_W2) + ((size_t)e * DM + 32 * nb) * DE, DE, 64.f, scr, lane); continue; }
        r -= I_2;
        { const int which = r / 8, q = r % 8, kb = q / 2, nb = q % 2;
          tr_item(which ? p.w_uv : p.w_uk, 64, 64, 64 * kb, 32 * nb, (bf16*)(ws + WS_WUKV) + (size_t)(which * 64 + 32 * nb) * 256, 256, p.kv_norm_g, scr, lane); }
    }
    const int gt = blockIdx.x * 512 + tid, NGT = gridDim.x * 512;
    for (int i = gt; i < 8 * 128 * 128; i += NGT) { const int ii = (i >> 7) & 127, j = i & 127; ((bf16*)(ws + WS_WSP))[i] = ((ii >> 6) >= (j >> 6)) ? (bf16)f2bf(p.w_sp[i]) : (bf16)0; }
    for (int i = gt; i < 48 * 2048; i += NGT) { const int n = i / 2048, k = i % 2048; float v = 0.f; if (n < 4) v = p.w_group[k * 4 + n]; else if (n < 36) v = p.w_expert[k * 32 + (n - 4)]; ((bf16*)(ws + WS_WR))[i] = (bf16)f2bf(v); }
    for (int i = gt; i < NT * 32; i += NGT) { const int tok = i >> 5, f = i & 31; const float ang = (float)p.pos[tok] * p.freqs[f]; float s, c; sincos_acc(ang, s, c); ((f32x2*)(ws + WS_CS))[i] = (f32x2){c, s}; }
}
__device__ __forceinline__ void ph_prep_ada(const P& p, LAS unsigned char* lds) {
    const int tid = otid();
    unsigned char* ws = p.ws;
    __syncthreads();
    LAS float* sl = (LAS float*)lds;
    LAS float* red = (LAS float*)(lds + 65536);
    for (int i = tid; i < 8 * 2048; i += 512) sl[i] = silu_f(p.c[i]);
    __syncthreads();
    for (int cb = blockIdx.x; cb < 256; cb += gridDim.x) {
        const int cg = tid % 12, kl = tid / 12, col0 = cb * 48 + 4 * cg;
        if (kl < 42) {
            f32x4 acc[8];
#pragma unroll
            for (int b = 0; b < 8; ++b) acc[b] = (f32x4){0.f, 0.f, 0.f, 0.f};
            for (int j0 = 0; j0 < 49; j0 += 7) {
                f32x4 w[7];
#pragma unroll
                for (int j = 0; j < 7; ++j) { const int k = kl + 42 * (j0 + j); w[j] = (k < 2048) ? __builtin_nontemporal_load((const f32x4*)(p.w_ada + (size_t)k * 12288 + col0)) : (f32x4){0.f, 0.f, 0.f, 0.f}; }
#pragma unroll
                for (int j = 0; j < 7; ++j) { const int k = kl + 42 * (j0 + j); const int kc = k < 2048 ? k : 2047;
#pragma unroll
                    for (int b = 0; b < 8; ++b) acc[b] += w[j] * sl[b * 2048 + kc]; }
            }
#pragma unroll
            for (int b = 0; b < 8; ++b)
#pragma unroll
                for (int e = 0; e < 4; ++e) red[(kl * 8 + b) * 48 + 4 * cg + e] = acc[b][e];
        }
        __syncthreads();
        if (tid < 384) { const int b = tid / 48, cc = tid % 48; float s = 0.f; for (int k = 0; k < 42; ++k) s += red[(k * 8 + b) * 48 + cc];
            ((float*)(ws + WS_MOD))[b * 12288 + cb * 48 + cc] = s + p.b_ada[cb * 48 + cc]; }
        __syncthreads();
    }
}

__device__ __forceinline__ void ph_h(const P& p) {
    const int tid = otid(), lane = tid & 63, wave = tid >> 6;
    const int gw = blockIdx.x * 8 + wave, NGW = gridDim.x * 8;
    const float* mod = (const float*)(p.ws + WS_MOD);
    bf16* H = (bf16*)(p.ws + WS_H);
    for (int m0 = 2 * gw; m0 < NT; m0 += 2 * NGW) {
        f32x4 v[2][8]; float ss[2] = {0.f, 0.f};
#pragma unroll
        for (int r = 0; r < 2; ++r) { const f32x4* xr = (const f32x4*)(p.x + (size_t)(m0 + r) * DM) + lane;
#pragma unroll
            for (int j = 0; j < 8; ++j) v[r][j] = __builtin_nontemporal_load(xr + 64 * j); }
#pragma unroll
        for (int r = 0; r < 2; ++r) {
            const int m = m0 + r, b = m >> 12;
#pragma unroll
            for (int j = 0; j < 8; ++j) ss[r] += v[r][j].x * v[r][j].x + v[r][j].y * v[r][j].y + v[r][j].z * v[r][j].z + v[r][j].w * v[r][j].w;
            const float rstd = 1.f / sqrtf(wave_sum(ss[r]) * (1.f / DM) + EPS);
            u32x2* o = (u32x2*)(H + (size_t)m * DM) + lane;
#pragma unroll
            for (int j = 0; j < 8; ++j) {
                const int col = 4 * lane + 256 * j;
                const f32x4 g = *(const f32x4*)(p.norm1_g + col), sh = *(const f32x4*)(mod + b * 12288 + col), sc = *(const f32x4*)(mod + b * 12288 + 2048 + col);
                const f32x4 h = v[r][j] * rstd * g * (sc + 1.f) + sh;
                o[64 * j] = (u32x2){pk2(h.x, h.y), pk2(h.z, h.w)};
                { int q8 = __builtin_amdgcn_cvt_pk_fp8_f32(h.x, h.y, 0, false); q8 = __builtin_amdgcn_cvt_pk_fp8_f32(h.z, h.w, q8, true); ((unsigned*)(p.ws + WS_H8 + (size_t)m * DM))[lane + 64 * j] = (unsigned)q8; }
            }
        }
    }
}


namespace pg8 {
constexpr int BM = 256, BK = 64, HALF = 128, HTB = HALF * BK * 2, STAGE_BYTES = 8 * HTB, NXCD = 8, WGM = 8;
__device__ __forceinline__ int lds_byte(int r, int c) { const int st = (r >> 4) * 2 + (c >> 5), rr = r & 15, cc = c & 31, ob = rr * 64 + cc * 2; return st * 1024 + (ob ^ (((ob >> 9) & 1) << 5)); }
__device__ __forceinline__ void stage_rc(int b, int& R, int& C) { const int st = b / 1024, sb = b % 1024, swz = sb ^ (((sb >> 9) & 1) << 5); R = (st >> 1) * 16 + swz / 64; C = (st & 1) * 32 + (swz % 64) / 2; }
__device__ __forceinline__ int perm32(int rho) { const int n = rho >> 4, i = rho & 15; return 8 * (i >> 2) + 4 * n + (i & 3); }
struct Unit { int pm, pn, e, p0, nv; };

typedef int v8i __attribute__((ext_vector_type(8)));
typedef int v4i __attribute__((ext_vector_type(4)));
__device__ __forceinline__ v8i cat8(bf16x8 lo, bf16x8 hi) { const v4i a = __builtin_bit_cast(v4i, lo), b = __builtin_bit_cast(v4i, hi); return __builtin_shufflevector(a, b, 0, 1, 2, 3, 4, 5, 6, 7); }
struct StaticOrder {
    int nM, nN, nwg, G, c;
    __device__ void init(int M, int N, int G_, int c_) { nM = M / BM; nN = N / BM; nwg = nM * nN; G = G_; c = c_; }
    __device__ bool next(int i, Unit& u) const {
        const long L = (long)i * G + c; if (L >= nwg) return false;
        int wgid = (int)L; { const int q = nwg / NXCD, r = nwg % NXCD, xcd = wgid % NXCD, off = wgid / NXCD; wgid = (xcd < r ? xcd * (q + 1) : r * (q + 1) + (xcd - r) * q) + off; }
        const int nig = WGM * nN, gid = wgid / nig, fm = gid * WGM, gsz = (nM - fm) < WGM ? (nM - fm) : WGM;
        u.pm = fm + ((wgid % nig) % gsz); u.pn = (wgid % nig) / gsz; u.e = 0; u.p0 = 0; u.nv = 256; return true;
    }
};

template <bool FP8> struct FragSel;
template <> struct FragSel<false> { struct A4 { bf16x8 f[4][2]; }; struct B2 { bf16x8 f[2][2]; }; };
template <> struct FragSel<true>  { struct A4 { v8i f[4]; };       struct B2 { v8i f[2]; }; };
template <bool FP8, class Epi, class Sched, class Ops>
__device__ __forceinline__ void gemm_phase(LAS unsigned char* lds, const Ops& O, const Sched& S, const Epi& E) {
    const int tid = otid(), wid = __builtin_amdgcn_readfirstlane(tid >> 6), lane = tid & 63, wr = wid >> 2, wc = wid & 3, fr = lane & 15, fq = lane >> 4;
    const int K = O.K, nt = K / BK;
    unsigned voffB[2], voffA[2];
    { int R0, C0, R1, C1; stage_rc(tid * 16, R0, C0); stage_rc(tid * 16 + 8192, R1, C1);
      const int Rb0 = Epi::PERM ? ((R0 & ~31) + perm32(R0 & 31)) : R0, Rb1 = Epi::PERM ? ((R1 & ~31) + perm32(R1 & 31)) : R1;
      voffB[0] = (unsigned)(Rb0 * K + C0) * 2u; voffB[1] = (unsigned)(Rb1 * K + C1) * 2u;
      voffA[0] = (unsigned)(R0 * K + C0) * 2u; voffA[1] = (unsigned)(R1 * K + C1) * 2u; }
    const size_t kstep = (size_t)(BK * 2);
    const size_t hstep = (size_t)HALF * K * 2;
    const unsigned ldsw = (unsigned)wid * 1024u;
    const int aoff = lds_byte(wr * 64 + fr, fq * 8), boff = lds_byte(wc * 32 + fr, fq * 8);
    const char* const Ab = (const char*)O.A;
#define PG8_SA(b, h) (((b) * 2 + (h)) * HTB)
#define PG8_SB(b, h) ((4 + (b) * 2 + (h)) * HTB)
#define PG8_STAGEB(bufoff, gbase) do { _Pragma("unroll") for (int _i = 0; _i < 2; ++_i) \
        __builtin_amdgcn_global_load_lds((const unsigned*)((const char*)(gbase) + voffB[_i]), (LAS unsigned*)(lds + (bufoff) + ldsw + _i * 8192), 16, 0, 0); } while (0)
#define PG8_STAGEA(bufoff, ub, h, kb) do { _Pragma("unroll") for (int _i = 0; _i < 2; ++_i) { \
        if constexpr (Ops::GATHER) { unsigned _v = ((h) ? vc1 : vc0)[_i]; asm volatile("" : "+v"(_v)); \
            __builtin_amdgcn_global_load_lds((const unsigned*)(Ab + (kb) + _v), (LAS unsigned*)(lds + (bufoff) + ldsw + _i * 8192), 16, 0, 0); } \
        else __builtin_amdgcn_global_load_lds((const unsigned*)(Ab + (ub) + (size_t)(h) * hstep + (kb) + voffA[_i]), (LAS unsigned*)(lds + (bufoff) + ldsw + _i * 8192), 16, 0, 0); } } while (0)
#define PG8_LDA(dst, b, h) do { _Pragma("unroll") for (int m = 0; m < 4; ++m) { const bf16x8 _l = *(const LAS bf16x8*)(lds + PG8_SA(b, h) + aoff + m * 2048), _h = *(const LAS bf16x8*)(lds + PG8_SA(b, h) + aoff + m * 2048 + 1024); \
        if constexpr (FP8) dst.f[m] = cat8(_l, _h); else { dst.f[m][0] = _l; dst.f[m][1] = _h; } } } while (0)
#define PG8_LDB(dst, b, h) do { _Pragma("unroll") for (int n = 0; n < 2; ++n) { const bf16x8 _l = *(const LAS bf16x8*)(lds + PG8_SB(b, h) + boff + n * 2048), _h = *(const LAS bf16x8*)(lds + PG8_SB(b, h) + boff + n * 2048 + 1024); \
        if constexpr (FP8) dst.f[n] = cat8(_l, _h); else { dst.f[n][0] = _l; dst.f[n][1] = _h; } } } while (0)
#define PG8_MMA(ai, bj, At, Bt) do { __builtin_amdgcn_s_setprio(1); _Pragma("unroll") for (int m = 0; m < 4; ++m) _Pragma("unroll") for (int n = 0; n < 2; ++n) { \
        if constexpr (FP8) { asm("v_mfma_scale_f32_16x16x128_f8f6f4 %0, %1, %2, %0, %3, %4 op_sel_hi:[0,0,0]" : "+v"(acc[ai][bj][m][n]) : "v"(Bt.f[n]), "v"(At.f[m]), "v"(sc_w), "v"(sc_a)); } \
        else { _Pragma("unroll") for (int k = 0; k < 2; ++k) acc[ai][bj][m][n] = __builtin_amdgcn_mfma_f32_16x16x32_bf16(Bt.f[n][k], At.f[m][k], acc[ai][bj][m][n], 0, 0, 0); } } \
        __builtin_amdgcn_s_setprio(0); } while (0)
#define PG8_WAIT_V(n) asm volatile("s_waitcnt vmcnt(" #n ")" ::: "memory")
#define PG8_WAIT_L(n) asm volatile("s_waitcnt lgkmcnt(" #n ")" ::: "memory")
#define PG8_BAR __builtin_amdgcn_s_barrier()
#define PG8_SCHED __builtin_amdgcn_sched_barrier(0)
    Unit cur, nxt; int ui = 0;
    if (!S.next(0, cur)) return;
    f32x4 acc[2][2][4][2];
#pragma unroll
    for (int a = 0; a < 2; ++a)
#pragma unroll
        for (int b = 0; b < 2; ++b)
#pragma unroll
            for (int m = 0; m < 4; ++m)
#pragma unroll
                for (int n = 0; n < 2; ++n) acc[a][b][m][n] = (f32x4){0.f, 0.f, 0.f, 0.f};
    typedef typename FragSel<FP8>::A4 FA; typedef typename FragSel<FP8>::B2 FB;
    FA At; FB B0, B1;
    const int sc_w = O.scale_w, sc_a = O.scale_a; (void)sc_w; (void)sc_a;
    unsigned vc0[2] = {0u, 0u}, vc1[2] = {0u, 0u};
    if constexpr (Ops::GATHER) O.a_off(cur, tid, vc0, vc1);
    size_t cU = O.a_base(cur);
    const char* cB = O.b_base(cur);
    PG8_STAGEB(PG8_SB(0, 0), cB); PG8_STAGEB(PG8_SB(0, 1), cB + hstep); PG8_STAGEA(PG8_SA(0, 0), cU, 0, 0); PG8_STAGEA(PG8_SA(0, 1), cU, 1, 0);
    if (wr == 1) PG8_BAR;
    PG8_WAIT_V(2); PG8_BAR;
    PG8_STAGEB(PG8_SB(1, 0), cB + kstep); PG8_STAGEA(PG8_SA(1, 0), cU, 0, kstep); PG8_STAGEB(PG8_SB(1, 1), cB + hstep + kstep);
    PG8_WAIT_V(6); PG8_BAR;
    for (;;) {
        const bool has_next = S.next(ui + 1, nxt);
        const char* nB = has_next ? O.b_base(nxt) : cB;
        const size_t nU = has_next ? O.a_base(nxt) : cU;
        for (int t = 0; t < nt; t += 2) {
            const bool last = (t == nt - 2);
            const size_t k1 = (size_t)(t + 1) * kstep;
            const size_t k2 = last ? 0 : (size_t)(t + 2) * kstep, k3 = k2 + kstep;
            const size_t u2 = last ? nU : cU;
            const char* b2 = last ? nB : cB + (size_t)(t + 2) * kstep; const char* b3 = b2 + kstep;
            unsigned vt1[2] = {vc1[0], vc1[1]};
            if constexpr (Ops::GATHER) { if (last && has_next) { unsigned n0[2], n1[2]; O.a_off(nxt, tid, n0, n1); vc0[0] = n0[0]; vc0[1] = n0[1]; vt1[0] = n1[0]; vt1[1] = n1[1]; } }
            PG8_LDB(B0, 0, 0); PG8_LDB(B1, 0, 1); PG8_SCHED; PG8_LDA(At, 0, 0); PG8_STAGEA(PG8_SA(1, 1), cU, 1, k1);
            if constexpr (Ops::GATHER) { vc1[0] = vt1[0]; vc1[1] = vt1[1]; }
            PG8_WAIT_V(8); PG8_WAIT_L(0); PG8_BAR; PG8_MMA(0, 0, At, B0); PG8_MMA(0, 1, At, B1); PG8_BAR; PG8_SCHED;
            PG8_LDA(At, 0, 1); PG8_STAGEB(PG8_SB(0, 0), b2); PG8_STAGEB(PG8_SB(0, 1), b2 + hstep); PG8_STAGEA(PG8_SA(0, 0), u2, 0, k2);
            PG8_WAIT_V(8); PG8_WAIT_L(0); PG8_BAR; PG8_MMA(1, 0, At, B0); PG8_MMA(1, 1, At, B1); PG8_BAR; PG8_SCHED;
            PG8_LDB(B0, 1, 0); PG8_LDB(B1, 1, 1); PG8_SCHED; PG8_LDA(At, 1, 0); PG8_STAGEA(PG8_SA(0, 1), u2, 1, k2);
            PG8_WAIT_V(8); PG8_WAIT_L(0); PG8_BAR; PG8_MMA(0, 0, At, B0); PG8_MMA(0, 1, At, B1); PG8_BAR; PG8_SCHED;
            PG8_LDA(At, 1, 1); PG8_STAGEB(PG8_SB(1, 0), b3); PG8_STAGEB(PG8_SB(1, 1), b3 + hstep); PG8_STAGEA(PG8_SA(1, 0), u2, 0, k3);
            PG8_WAIT_V(8); PG8_WAIT_L(0); PG8_BAR; PG8_MMA(1, 0, At, B0); PG8_MMA(1, 1, At, B1); PG8_BAR; PG8_SCHED;
        }
        if (wr == 0) PG8_BAR;
        if constexpr (FP8) asm volatile("s_nop 15\n\ts_nop 15" ::: "memory");
        E(acc, cur, wr, wc, fr, fq);
        if (!has_next) break;
#pragma unroll
        for (int a = 0; a < 2; ++a)
#pragma unroll
            for (int b = 0; b < 2; ++b)
#pragma unroll
                for (int m = 0; m < 4; ++m)
#pragma unroll
                    for (int n = 0; n < 2; ++n) acc[a][b][m][n] = (f32x4){0.f, 0.f, 0.f, 0.f};
        cur = nxt; cB = nB; cU = nU; ++ui;
        if (wr == 1) PG8_BAR;
    }
    PG8_WAIT_V(0);
    PG8_BAR;
#undef PG8_SA
#undef PG8_SB
#undef PG8_STAGEA
#undef PG8_STAGEB
#undef PG8_LDA
#undef PG8_LDB
#undef PG8_MMA
#undef PG8_WAIT_V
#undef PG8_WAIT_L
#undef PG8_BAR
#undef PG8_SCHED
}
}

struct OpsDense {
    static constexpr bool GATHER = false;
    const bf16* A; const bf16* Bt; int K; static constexpr int scale_w = 0x7f, scale_a = 0x7f;
    __device__ __forceinline__ const char* b_base(const pg8::Unit& u) const { return (const char*)Bt + (size_t)u.pn * 256 * K * 2; }
    __device__ __forceinline__ size_t a_base(const pg8::Unit& u) const { return (size_t)u.pm * 256 * K * 2; }
    __device__ __forceinline__ void a_off(const pg8::Unit&, int, unsigned (&)[2], unsigned (&)[2]) const {}
};
struct EpiInproj {
    static constexpr bool PERM = true;
    bf16* Oq; int coff; int nact;
    __device__ __forceinline__ void operator()(const f32x4 (&acc)[2][2][4][2], const pg8::Unit& u, int wr, int wc, int fr, int fq) const {
        const int row0 = u.pm * 256 + wr * 64 + fr, col0 = coff + u.pn * 256 + wc * 32 + 8 * fq;
        const bool act = u.pn < nact;
#pragma unroll
        for (int ai = 0; ai < 2; ++ai)
#pragma unroll
            for (int m = 0; m < 4; ++m) { bf16* rowp = Oq + (size_t)(row0 + ai * 128 + m * 16) * NPROJ + col0;
#pragma unroll
                for (int bj = 0; bj < 2; ++bj) { f32x4 v0 = acc[ai][bj][m][0], v1 = acc[ai][bj][m][1];
                    if (act) { v0.x = gelu_tanh(v0.x); v0.y = gelu_tanh(v0.y); v0.z = gelu_tanh(v0.z); v0.w = gelu_tanh(v0.w); v1.x = gelu_tanh(v1.x); v1.y = gelu_tanh(v1.y); v1.z = gelu_tanh(v1.z); v1.w = gelu_tanh(v1.w); }
                    u32x4 w; w.x = pk2(v0.x, v0.y); w.y = pk2(v0.z, v0.w); w.z = pk2(v1.x, v1.y); w.w = pk2(v1.z, v1.w);
                    __builtin_nontemporal_store(w, (u32x4*)(rowp + bj * 128)); } }
    }
};
struct EpiOutproj {
    static constexpr bool PERM = true;
    const float* x; const float* mod; bf16* x1; const float* rsa;
    __device__ __forceinline__ void operator()(const f32x4 (&acc)[2][2][4][2], const pg8::Unit& u, int wr, int wc, int fr, int fq) const {
        const int row0 = u.pm * 256 + wr * 64 + fr, col0 = u.pn * 256 + wc * 32 + 8 * fq;
        const int b = (u.pm * 256) >> 12;
        f32x4 g[2][2];
#pragma unroll
        for (int bj = 0; bj < 2; ++bj)
#pragma unroll
            for (int n = 0; n < 2; ++n) g[bj][n] = *(const f32x4*)(mod + b * 12288 + 2 * 2048 + col0 + bj * 128 + 4 * n);
#pragma unroll
        for (int ai = 0; ai < 2; ++ai)
#pragma unroll
            for (int m = 0; m < 4; ++m) { const size_t ro = (size_t)(row0 + ai * 128 + m * 16) * DM + col0; const float rsc = rsa[row0 + ai * 128 + m * 16];
#pragma unroll
                for (int bj = 0; bj < 2; ++bj) { const f32x4 x0 = *(const f32x4*)(x + ro + bj * 128), x1v = *(const f32x4*)(x + ro + bj * 128 + 4);
                    const f32x4 v0 = x0 + g[bj][0] * (acc[ai][bj][m][0] * rsc), v1 = x1v + g[bj][1] * (acc[ai][bj][m][1] * rsc);
                    *(u32x4*)(x1 + ro + bj * 128) = (u32x4){pk2(v0.x, v0.y), pk2(v0.z, v0.w), pk2(v1.x, v1.y), pk2(v1.z, v1.w)}; } }
    }
};
constexpr int LDS_MOE_EBASE = 131072, LDS_MOE_TILE = 131072 + 256;
__device__ __forceinline__ int moe_tables(const P& p, LAS unsigned char* lds) {
    const unsigned* cnt = (const unsigned*)(p.ws + WS_CTL) + CW_CNT;
    LAS int* ebase = (LAS int*)(lds + LDS_MOE_EBASE); LAS int* tile_e = (LAS int*)(lds + LDS_MOE_TILE);
    __syncthreads();
    if (threadIdx.x == 0) { int run = 0; for (int e = 0; e < NE; ++e) { ebase[e] = run; run += ((int)cnt[e] + 255) & ~255; } ebase[NE] = run; }
    __syncthreads();
    const int ntl = ebase[NE] >> 8;
    for (int t = threadIdx.x; t < ntl; t += 512) { int e = 0; while (e < NE - 1 && ebase[e + 1] <= 256 * t) ++e; tile_e[t] = e; }
    __syncthreads();
    return ntl;
}
struct MoeSched {
    int ntl, c; const LAS int* tile_e; const LAS int* ebase; const unsigned* cnt;
    __device__ __forceinline__ bool next(int i, pg8::Unit& u) const {
        const int x = c & 7, j = c >> 3;
        const int st = 32 * i + 4 * x + (j >> 3);
        if (st >= ntl) return false;
        const int e = tile_e[st];
        u.pm = st; u.pn = j & 7; u.e = e; u.p0 = 256 * st - ebase[e]; u.nv = (int)cnt[e] - u.p0; return true;
    }
};
struct OpsMoe1 {
    static constexpr bool GATHER = true;
    const bf16* A; const bf16* Bt; int K; const int* list; static constexpr int scale_w = 0x7c, scale_a = 0x7c;
    __device__ __forceinline__ const char* b_base(const pg8::Unit& u) const { return (const char*)Bt + (size_t)(u.e * 8 + u.pn) * 256 * DM; }
    __device__ __forceinline__ size_t a_base(const pg8::Unit&) const { return 0; }
    __device__ __forceinline__ void a_off(const pg8::Unit& u, int tid, unsigned (&v0)[2], unsigned (&v1)[2]) const {
        int R0, C0, R1, C1; pg8::stage_rc(tid * 16, R0, C0); pg8::stage_rc(tid * 16 + 8192, R1, C1);
        const int* le = list + (size_t)u.e * NT + u.p0; const int lim = u.nv - 1;
        const int r00 = R0 < lim ? R0 : lim, r01 = R1 < lim ? R1 : lim, r10 = (128 + R0) < lim ? (128 + R0) : lim, r11 = (128 + R1) < lim ? (128 + R1) : lim;
        v0[0] = (unsigned)le[r00] * (unsigned)DM + C0 * 2u; v0[1] = (unsigned)le[r01] * (unsigned)DM + C1 * 2u;
        v1[0] = (unsigned)le[r10] * (unsigned)DM + C0 * 2u; v1[1] = (unsigned)le[r11] * (unsigned)DM + C1 * 2u;
    }
};
struct OpsMoe2 {
    static constexpr bool GATHER = false;
    const bf16* A; const bf16* Bt; int K; static constexpr int scale_w = 0x7b, scale_a = 0x7b;
    __device__ __forceinline__ const char* b_base(const pg8::Unit& u) const { return (const char*)Bt + ((size_t)u.e * DM + (size_t)u.pn * 256) * DE; }
    __device__ __forceinline__ size_t a_base(const pg8::Unit& u) const { return (size_t)u.pm * 256 * DE; }
    __device__ __forceinline__ void a_off(const pg8::Unit&, int, unsigned (&)[2], unsigned (&)[2]) const {}
};
struct EpiMoe1 {
    static constexpr bool PERM = true;
    bf16* act;
    __device__ __forceinline__ void operator()(const f32x4 (&acc)[2][2][4][2], const pg8::Unit& u, int wr, int wc, int fr, int fq) const {
        const int row0 = u.pm * 256 + wr * 64 + fr, col0 = u.pn * 128 + wc * 32 + 8 * fq;
#pragma unroll
        for (int ai = 0; ai < 2; ++ai)
#pragma unroll
            for (int m = 0; m < 4; ++m) {
                const f32x4 a0 = acc[ai][0][m][0], a1 = acc[ai][0][m][1], g0 = acc[ai][1][m][0], g1 = acc[ai][1][m][1];
                int w0 = __builtin_amdgcn_cvt_pk_fp8_f32(4.f * silu_f(a0.x) * g0.x, 4.f * silu_f(a0.y) * g0.y, 0, false); w0 = __builtin_amdgcn_cvt_pk_fp8_f32(4.f * silu_f(a0.z) * g0.z, 4.f * silu_f(a0.w) * g0.w, w0, true);
                int w1 = __builtin_amdgcn_cvt_pk_fp8_f32(4.f * silu_f(a1.x) * g1.x, 4.f * silu_f(a1.y) * g1.y, 0, false); w1 = __builtin_amdgcn_cvt_pk_fp8_f32(4.f * silu_f(a1.z) * g1.z, 4.f * silu_f(a1.w) * g1.w, w1, true);
                *(u32x2*)((unsigned char*)act + (size_t)(row0 + ai * 128 + m * 16) * DE + col0) = (u32x2){(unsigned)w0, (unsigned)w1}; }
    }
};
struct EpiMoe2 {
    static constexpr bool PERM = true;
    bf16* ym;
    __device__ __forceinline__ void operator()(const f32x4 (&acc)[2][2][4][2], const pg8::Unit& u, int wr, int wc, int fr, int fq) const {
        const int row0 = u.pm * 256 + wr * 64 + fr, col0 = u.pn * 256 + wc * 32 + 8 * fq;
#pragma unroll
        for (int ai = 0; ai < 2; ++ai)
#pragma unroll
            for (int m = 0; m < 4; ++m) { unsigned char* rowp = (unsigned char*)ym + (size_t)(row0 + ai * 128 + m * 16) * DM + col0;
#pragma unroll
                for (int bj = 0; bj < 2; ++bj) { const f32x4 v0 = acc[ai][bj][m][0] * 16.f, v1 = acc[ai][bj][m][1] * 16.f;
                    int w0 = __builtin_amdgcn_cvt_pk_fp8_f32(v0.x, v0.y, 0, false); w0 = __builtin_amdgcn_cvt_pk_fp8_f32(v0.z, v0.w, w0, true);
                    int w1 = __builtin_amdgcn_cvt_pk_fp8_f32(v1.x, v1.y, 0, false); w1 = __builtin_amdgcn_cvt_pk_fp8_f32(v1.z, v1.w, w1, true);
                    *(u32x2*)(rowp + bj * 128) = (u32x2){(unsigned)w0, (unsigned)w1}; } }
    }
};
struct OpsDense8 {
    static constexpr bool GATHER = false;
    const bf16* A; const bf16* Bt; int K; static constexpr int scale_w = 0x7c, scale_a = 0x7c;
    __device__ __forceinline__ const char* b_base(const pg8::Unit& u) const { return (const char*)Bt + (size_t)u.pn * 256 * K * 2; }
    __device__ __forceinline__ size_t a_base(const pg8::Unit& u) const { return (size_t)u.pm * 256 * K * 2; }
    __device__ __forceinline__ void a_off(const pg8::Unit&, int, unsigned (&)[2], unsigned (&)[2]) const {}
};
__device__ __forceinline__ void ph_inproj_fp8(const P& p, LAS unsigned char* lds) {
    OpsDense8 O{(const bf16*)(p.ws + WS_H8), (const bf16*)(p.ws + WS_WIN8), DM / 2};
    pg8::StaticOrder S; S.init(NT, 3072, gridDim.x, blockIdx.x);
    EpiInproj E{(bf16*)(p.ws + WS_PROJ), 0, 8};
    pg8::gemm_phase<true>(lds, O, S, E);
}
__device__ __forceinline__ void ph_inproj_bf16(const P& p, LAS unsigned char* lds) {
    OpsDense O{(const bf16*)(p.ws + WS_H), (const bf16*)(p.ws + WS_WIN) + (size_t)3072 * DM, DM};
    pg8::StaticOrder S; S.init(NT, 1024, gridDim.x, blockIdx.x);
    EpiInproj E{(bf16*)(p.ws + WS_PROJ), 3072, 0};
    pg8::gemm_phase<false>(lds, O, S, E);
}
__device__ __forceinline__ void ph_inproj(const P& p, LAS unsigned char* lds) {
    if (blockIdx.x & 1) { ph_inproj_bf16(p, lds); ph_inproj_fp8(p, lds); } else { ph_inproj_fp8(p, lds); ph_inproj_bf16(p, lds); }
}
__device__ __forceinline__ void ph_outproj(const P& p, LAS unsigned char* lds) {
    OpsDense8 O{(const bf16*)(p.ws + WS_Y8), (const bf16*)(p.ws + WS_WOUT), DM / 2};
    pg8::StaticOrder S; S.init(NT, DM, gridDim.x, blockIdx.x);
    EpiOutproj E{p.x, (const float*)(p.ws + WS_MOD), (bf16*)(p.ws + WS_X1), (const float*)(p.ws + WS_SSQ)};
    pg8::gemm_phase<true>(lds, O, S, E);
}
__device__ __forceinline__ void ph_moe1(const P& p, LAS unsigned char* lds) {
    const int ntl = moe_tables(p, lds);
    int i_lo, i_hi;
    {
        constexpr int NW2 = 32 * 512, DU = 64;
        const int c = (int)blockIdx.x;
        int R = ntl - 256; R = R < 0 ? 0 : (R > 32 ? 32 : R);
        const int n9 = 8 * R, n8 = 256 - n9;
        int b_it = (NW2 - n8 * DU) / 256; b_it = b_it < 0 ? 0 : ((b_it + 7) & ~7);
        int a_it = n8 > 0 ? ((NW2 - n9 * b_it + n8 - 1) / n8 + 7) & ~7 : 0;
        if (n8 == 0) b_it = NW2 / 256;
        int r9 = 0;
        for (int k = 0; k < c; ++k) r9 += (4 * (k & 7) + (k >> 6) < R) ? 1 : 0;
        const bool h9 = 4 * (c & 7) + (c >> 6) < R;
        i_lo = r9 * b_it + (c - r9) * a_it; i_hi = i_lo + (h9 ? b_it : a_it);
        i_lo = i_lo < NW2 ? i_lo : NW2; i_hi = i_hi < NW2 ? i_hi : NW2; if (c == 255) i_hi = NW2;
    }
    const int wave = otid() >> 6;
    if (blockIdx.x & 1) { __syncthreads(); exp_convert_range(p, lds, i_lo + wave, i_hi, 8); __syncthreads(); }
    OpsMoe1 O{(const bf16*)(p.ws + WS_H), (const bf16*)(p.ws + WS_W13), DM / 2, (const int*)(p.ws + WS_LIST)};
    MoeSched S{ntl, (int)blockIdx.x, (const LAS int*)(lds + LDS_MOE_TILE), (const LAS int*)(lds + LDS_MOE_EBASE), (const unsigned*)(p.ws + WS_CTL) + CW_CNT};
    EpiMoe1 E{(bf16*)(p.ws + WS_ACT)};
    pg8::gemm_phase<true>(lds, O, S, E);
    if (!(blockIdx.x & 1)) { __syncthreads(); exp_convert_range(p, lds, i_lo + wave, i_hi, 8); __syncthreads(); }
}
__device__ __forceinline__ void ph_moe2(const P& p, LAS unsigned char* lds) {
    const int ntl = moe_tables(p, lds);
    OpsMoe2 O{(const bf16*)(p.ws + WS_ACT), (const bf16*)(p.ws + WS_W2), DE / 2};
    MoeSched S{ntl, (int)blockIdx.x, (const LAS int*)(lds + LDS_MOE_TILE), (const LAS int*)(lds + LDS_MOE_EBASE), (const unsigned*)(p.ws + WS_CTL) + CW_CNT};
    EpiMoe2 E{(bf16*)(p.ws + WS_YMOE)};
    pg8::gemm_phase<true>(lds, O, S, E);
}

__device__ __forceinline__ unsigned sortkey(float f) { const unsigned u = __float_as_uint(f); return (u & 0x80000000u) ? ~u : (u | 0x80000000u); }
__device__ __forceinline__ int cnt_ge8(const unsigned (&K)[64], int g, unsigned cand) {
    unsigned long long m0, m1, m2, m3, m4, m5, m6, m7;
    asm("v_cmp_ge_u32_e64 %0, %8, %16\n\tv_cmp_ge_u32_e64 %1, %9, %16\n\tv_cmp_ge_u32_e64 %2, %10, %16\n\tv_cmp_ge_u32_e64 %3, %11, %16\n\t"
        "v_cmp_ge_u32_e64 %4, %12, %16\n\tv_cmp_ge_u32_e64 %5, %13, %16\n\tv_cmp_ge_u32_e64 %6, %14, %16\n\tv_cmp_ge_u32_e64 %7, %15, %16"
        : "=&s"(m0), "=&s"(m1), "=&s"(m2), "=&s"(m3), "=&s"(m4), "=&s"(m5), "=&s"(m6), "=&s"(m7)
        : "v"(K[8 * g]), "v"(K[8 * g + 1]), "v"(K[8 * g + 2]), "v"(K[8 * g + 3]), "v"(K[8 * g + 4]), "v"(K[8 * g + 5]), "v"(K[8 * g + 6]), "v"(K[8 * g + 7]), "s"(cand));
    return (__popcll(m0) + __popcll(m1)) + (__popcll(m2) + __popcll(m3)) + ((__popcll(m4) + __popcll(m5)) + (__popcll(m6) + __popcll(m7)));
}
__device__ __forceinline__ int cnt_ge(unsigned k, unsigned cand) { unsigned long long m; asm("v_cmp_ge_u32_e64 %0, %1, %2" : "=s"(m) : "v"(k), "s"(cand)); return __popcll(m); }
__device__ __forceinline__ unsigned mbcnt64(unsigned long long m) { return __builtin_amdgcn_mbcnt_hi((unsigned)(m >> 32), __builtin_amdgcn_mbcnt_lo((unsigned)m, 0u)); }
__device__ __forceinline__ void ds_read_tr16x2(unsigned a0, unsigned a1, u32x2& r0, u32x2& r1) { asm volatile("ds_read_b64_tr_b16 %0, %2\n\tds_read_b64_tr_b16 %1, %3\n\ts_waitcnt lgkmcnt(0)" : "=&v"(r0), "=&v"(r1) : "v"(a0), "v"(a1) : "memory"); }
__device__ __forceinline__ void ds_read_tr16x8(unsigned a0, unsigned a1, u32x2 (&r)[4], u32x2 (&q)[4]) {
    asm volatile("ds_read_b64_tr_b16 %0, %8\n\tds_read_b64_tr_b16 %4, %9\n\tds_read_b64_tr_b16 %1, %8 offset:32\n\tds_read_b64_tr_b16 %5, %9 offset:32\n\t"
                 "ds_read_b64_tr_b16 %2, %8 offset:64\n\tds_read_b64_tr_b16 %6, %9 offset:64\n\tds_read_b64_tr_b16 %3, %8 offset:96\n\tds_read_b64_tr_b16 %7, %9 offset:96\n\ts_waitcnt lgkmcnt(0)"
                 : "=&v"(r[0]), "=&v"(r[1]), "=&v"(r[2]), "=&v"(r[3]), "=&v"(q[0]), "=&v"(q[1]), "=&v"(q[2]), "=&v"(q[3]) : "v"(a0), "v"(a1) : "memory");
}
__device__ __forceinline__ void rope8(const u32x4 lo, const u32x4 hi, const f32x2 (&cs)[8], u32x4& olo, u32x4& ohi) {
    float a[8] = {bflo(lo.x), bfhi(lo.x), bflo(lo.y), bfhi(lo.y), bflo(lo.z), bfhi(lo.z), bflo(lo.w), bfhi(lo.w)};
    float c[8] = {bflo(hi.x), bfhi(hi.x), bflo(hi.y), bfhi(hi.y), bflo(hi.z), bfhi(hi.z), bflo(hi.w), bfhi(hi.w)};
    float r1[8], r2[8];
#pragma unroll
    for (int i = 0; i < 8; ++i) { r1[i] = a[i] * cs[i].x - c[i] * cs[i].y; r2[i] = a[i] * cs[i].y + c[i] * cs[i].x; }
    olo = (u32x4){pk2(r1[0], r1[1]), pk2(r1[2], r1[3]), pk2(r1[4], r1[5]), pk2(r1[6], r1[7])};
    ohi = (u32x4){pk2(r2[0], r2[1]), pk2(r2[2], r2[3]), pk2(r2[4], r2[5]), pk2(r2[6], r2[7])};
}
#define AS_BF8(v) __builtin_bit_cast(bf16x8, v)


constexpr int GM_STRIDE = 288;
__device__ __forceinline__ void gm_ln_load(const P& p, int tok0, int g, int wave, int lane, u32x4 (&raw)[4]) {
    const bf16* PR = (const bf16*)(p.ws + WS_PROJ);
    const int cl = lane & 15;
#pragma unroll
    for (int ps = 0; ps < 4; ++ps) { const int j = 16 * wave + 4 * ps + (lane >> 4); raw[ps] = *(const u32x4*)(PR + (size_t)(tok0 + j) * NPROJ + C_V + g * 128 + 8 * cl); }
}
__device__ __forceinline__ void gm_ln_write(const P& p, LAS unsigned char* img, int g, int wave, int lane, const u32x4 (&rawv)[4]) {
    const int cl = lane & 15;
    const f32x4 ga = *(const f32x4*)(p.v_norm_g + g * 128 + 8 * cl), gb = *(const f32x4*)(p.v_norm_g + g * 128 + 8 * cl + 4);
    const f32x4 ba = *(const f32x4*)(p.v_norm_b + g * 128 + 8 * cl), bb = *(const f32x4*)(p.v_norm_b + g * 128 + 8 * cl + 4);
#pragma unroll
    for (int ps = 0; ps < 4; ++ps) {
        const int j = 16 * wave + 4 * ps + (lane >> 4);
        const u32x4 raw = rawv[ps];
        float v[8] = {bflo(raw.x), bfhi(raw.x), bflo(raw.y), bfhi(raw.y), bflo(raw.z), bfhi(raw.z), bflo(raw.w), bfhi(raw.w)};
        float sm = ((v[0] + v[1]) + (v[2] + v[3])) + ((v[4] + v[5]) + (v[6] + v[7]));
        sm = row16_sum(sm);
        const float mu = sm * (1.f / 128.f);
        float q = 0.f;
#pragma unroll
        for (int i = 0; i < 8; ++i) { v[i] -= mu; q += v[i] * v[i]; }
        q = row16_sum(q);
        const float rs = 1.f / sqrtf(q * (1.f / 128.f) + EPS);
        u32x4 o;
        o.x = pk2(v[0] * rs * ga.x + ba.x, v[1] * rs * ga.y + ba.y); o.y = pk2(v[2] * rs * ga.z + ba.z, v[3] * rs * ga.w + ba.w);
        o.z = pk2(v[4] * rs * gb.x + bb.x, v[5] * rs * gb.y + bb.y); o.w = pk2(v[6] * rs * gb.z + bb.z, v[7] * rs * gb.w + bb.w);
        *(LAS u32x4*)(img + j * GM_STRIDE + 16 * cl) = o;
    }
}
__device__ __forceinline__ void ph_gmlp_kv(const P& p, LAS unsigned char* lds) {
    const int tid = otid(), lane = tid & 63, wave = __builtin_amdgcn_readfirstlane(tid >> 6), fr = lane & 15, fq = lane >> 4;
    const bf16* PR = (const bf16*)(p.ws + WS_PROJ); const bf16* WSP = (const bf16*)(p.ws + WS_WSP); bf16* Y = (bf16*)(p.ws + WS_Y);
    for (int u = blockIdx.x; u < NB * 32; u += gridDim.x) {
        const int tok0 = u * 128;
        const int irow = 16 * wave + fr;
        const size_t tokr = (size_t)(tok0 + irow);
        const int ns = (wave < 4) ? 2 : 4;
        float ssq = 0.f;
        u32x4 raw[4]; u32x2 uu[8], un[8]; u32x4 wf[4], wn[4];
#define GM_LOAD_U(dst, g) do { _Pragma("unroll") for (int ct = 0; ct < 8; ++ct) dst[ct] = *(const u32x2*)(PR + tokr * NPROJ + C_U + (g) * 128 + 16 * ct + 4 * fq); } while (0)
#define GM_LOAD_W(dst, g) do { _Pragma("unroll") for (int s4 = 0; s4 < 4; ++s4) if (s4 < ns) { const bf16* wp = WSP + (size_t)(g) * 16384 + (size_t)irow * 128 + 32 * s4 + 4 * fq; \
            const u32x2 w0 = *(const u32x2*)wp, w1 = *(const u32x2*)(wp + 16); dst[s4] = (u32x4){w0.x, w0.y, w1.x, w1.y}; } } while (0)
        __syncthreads();
        gm_ln_load(p, tok0, 0, wave, lane, raw); GM_LOAD_U(uu, 0); GM_LOAD_W(wf, 0);
        gm_ln_write(p, lds, 0, wave, lane, raw);
#pragma unroll 1
        for (int g = 0; g < 8; ++g) {
            LAS unsigned char* img = lds + (g & 1) * (128 * GM_STRIDE);
            asm volatile("s_waitcnt lgkmcnt(0)" ::: "memory");
            __syncthreads();
            if (g < 7) { gm_ln_load(p, tok0, g + 1, wave, lane, raw); GM_LOAD_U(un, g + 1); GM_LOAD_W(wn, g + 1); }
            f32x4 acc[8];
#pragma unroll
            for (int ct = 0; ct < 8; ++ct) acc[ct] = (f32x4){0.f, 0.f, 0.f, 0.f};
            const unsigned ibase = (unsigned)(size_t)img;
            const int q = (lane & 15) >> 2, pp = lane & 3;
#pragma unroll
            for (int s4 = 0; s4 < 4; ++s4) if (s4 < ns) {
                const unsigned r0 = ibase + (unsigned)((32 * s4 + 4 * fq + q) * GM_STRIDE + 8 * pp), r1 = r0 + 16 * GM_STRIDE;
#pragma unroll
                for (int c4 = 0; c4 < 2; ++c4) {
                    u32x2 x0[4], x1[4]; ds_read_tr16x8(r0 + 128 * c4, r1 + 128 * c4, x0, x1);
#pragma unroll
                    for (int c = 0; c < 4; ++c) { const u32x4 av = {x0[c].x, x0[c].y, x1[c].x, x1[c].y};
                        acc[4 * c4 + c] = __builtin_amdgcn_mfma_f32_16x16x32_bf16(AS_BF8(av), AS_BF8(wf[s4]), acc[4 * c4 + c], 0, 0, 0); }
                }
            }
            const float bias = p.b_sp[g * 128 + irow];
#pragma unroll
            for (int ct = 0; ct < 8; ++ct) {
                const u32x2 ur = uu[ct];
                const float y0 = bflo(ur.x) * (acc[ct].x + bias), y1 = bfhi(ur.x) * (acc[ct].y + bias), y2 = bflo(ur.y) * (acc[ct].z + bias), y3 = bfhi(ur.y) * (acc[ct].w + bias);
                ssq += (y0 * y0 + y1 * y1) + (y2 * y2 + y3 * y3);
                { int q8 = __builtin_amdgcn_cvt_pk_fp8_f32(4.f * y0, 4.f * y1, 0, false); q8 = __builtin_amdgcn_cvt_pk_fp8_f32(4.f * y2, 4.f * y3, q8, true);
                  *(unsigned*)((unsigned char*)(p.ws + WS_Y8) + tokr * DM + g * 128 + 16 * ct + 4 * fq) = (unsigned)q8; }
            }
            if (g < 7) { gm_ln_write(p, lds + ((g + 1) & 1) * (128 * GM_STRIDE), g + 1, wave, lane, raw);
#pragma unroll
                for (int ct = 0; ct < 8; ++ct) uu[ct] = un[ct];
#pragma unroll
                for (int s4 = 0; s4 < 4; ++s4) wf[s4] = wn[s4]; }
        }
#undef GM_LOAD_U
#undef GM_LOAD_W
        ssq += __shfl_xor(ssq, 16); ssq += __shfl_xor(ssq, 32);
        const float rsa = 1.f / sqrtf(ssq * (1.f / 1024.f) + EPS);
        if (fq == 0) ((float*)(p.ws + WS_SSQ))[tokr] = rsa * 0.25f;
        {
            const bf16* WU = (const bf16*)(p.ws + WS_WUKV);
            bf16* KB = (bf16*)(p.ws + WS_KB); bf16* VB = (bf16*)(p.ws + WS_VB); bf16* KI = (bf16*)(p.ws + WS_KIDX);
            const f32x2* CS = (const f32x2*)(p.ws + WS_CS);
            const size_t tok = tokr;
            bf16x8 af[8]; float sq = 0.f;
#pragma unroll
            for (int s8 = 0; s8 < 8; ++s8) { const u32x4 t = *(const u32x4*)(PR + tok * NPROJ + C_CKV + 32 * s8 + 8 * fq); af[s8] = AS_BF8(t);
                const float e0 = bflo(t.x), e1 = bfhi(t.x), e2 = bflo(t.y), e3 = bfhi(t.y), e4 = bflo(t.z), e5 = bfhi(t.z), e6 = bflo(t.w), e7 = bfhi(t.w);
                sq += ((e0 * e0 + e1 * e1) + (e2 * e2 + e3 * e3)) + ((e4 * e4 + e5 * e5) + (e6 * e6 + e7 * e7)); }
            sq += __shfl_xor(sq, 16); sq += __shfl_xor(sq, 32);
            const float rs = 1.f / sqrtf(sq * (1.f / 256.f) + EPS);
            f32x4 o[8];
#pragma unroll
            for (int nt = 0; nt < 8; ++nt) { o[nt] = (f32x4){0.f, 0.f, 0.f, 0.f};
                unsigned woff = (unsigned)((16 * nt + fr) * 256 + 8 * fq) * 2u; asm volatile("" : "+v"(woff));
                const char* wb = (const char*)WU + woff;
#pragma unroll
                for (int s8 = 0; s8 < 8; ++s8) { const bf16x8 wv = *(const bf16x8*)(wb + 64 * s8);
                    o[nt] = __builtin_amdgcn_mfma_f32_16x16x32_bf16(wv, af[s8], o[nt], 0, 0, 0); }
                o[nt] = o[nt] * rs; __builtin_amdgcn_sched_barrier(0); }
#pragma unroll
            for (int nt = 0; nt < 2; ++nt) {
                const f32x4 c01 = *(const f32x4*)(CS + tok * 32 + 16 * nt + 4 * fq), c23 = *(const f32x4*)(CS + tok * 32 + 16 * nt + 4 * fq + 2);
                const f32x4 x1 = o[nt], x2 = o[nt + 2];
                const f32x4 cs = {c01.x, c01.z, c23.x, c23.z}, sn = {c01.y, c01.w, c23.y, c23.w};
                const f32x4 r1 = x1 * cs - x2 * sn, r2 = x1 * sn + x2 * cs;
                *(u32x2*)(KB + tok * 64 + 16 * nt + 4 * fq) = (u32x2){pk2(r1.x, r1.y), pk2(r1.z, r1.w)};
                *(u32x2*)(KB + tok * 64 + 32 + 16 * nt + 4 * fq) = (u32x2){pk2(r2.x, r2.y), pk2(r2.z, r2.w)};
            }
#pragma unroll
            for (int nt = 4; nt < 8; ++nt) *(u32x2*)(VB + tok * 64 + 16 * (nt - 4) + 4 * fq) = (u32x2){pk2(o[nt].x, o[nt].y), pk2(o[nt].z, o[nt].w)};
            {
                const u32x4 lo = *(const u32x4*)(PR + tok * NPROJ + C_KI + 8 * fq), hi = *(const u32x4*)(PR + tok * NPROJ + C_KI + 32 + 8 * fq);
                float a[8] = {bflo(lo.x), bfhi(lo.x), bflo(lo.y), bfhi(lo.y), bflo(lo.z), bfhi(lo.z), bflo(lo.w), bfhi(lo.w)};
                float c[8] = {bflo(hi.x), bfhi(hi.x), bflo(hi.y), bfhi(hi.y), bflo(hi.z), bfhi(hi.z), bflo(hi.w), bfhi(hi.w)};
                float s2 = 0.f;
#pragma unroll
                for (int i = 0; i < 8; ++i) s2 += a[i] * a[i] + c[i] * c[i];
                s2 += __shfl_xor(s2, 16); s2 += __shfl_xor(s2, 32);
                const float r = 1.f / sqrtf(s2 * (1.f / 64.f) + EPS);
                float r1[8], r2[8];
#pragma unroll
                for (int i = 0; i < 8; ++i) { const f32x2 cs = CS[tok * 32 + 8 * fq + i];
                    const float x1 = a[i] * r * p.kidx_norm_g[8 * fq + i], x2 = c[i] * r * p.kidx_norm_g[32 + 8 * fq + i];
                    r1[i] = x1 * cs.x - x2 * cs.y; r2[i] = x1 * cs.y + x2 * cs.x; }
                *(u32x4*)(KI + tok * 64 + 8 * fq) = (u32x4){pk2(r1[0], r1[1]), pk2(r1[2], r1[3]), pk2(r1[4], r1[5]), pk2(r1[6], r1[7])};
                *(u32x4*)(KI + tok * 64 + 32 + 8 * fq) = (u32x4){pk2(r2[0], r2[1]), pk2(r2[2], r2[3]), pk2(r2[4], r2[5]), pk2(r2[6], r2[7])};
            }
        }
    }
}

__device__ __forceinline__ void ph_attn(const P& p, LAS unsigned char* lds) {
    const int tid = otid(), lane0 = tid & 63, wave = __builtin_amdgcn_readfirstlane(tid >> 6);
    const bf16* PR = (const bf16*)(p.ws + WS_PROJ);
    const bf16* KB = (const bf16*)(p.ws + WS_KB); const bf16* VB = (const bf16*)(p.ws + WS_VB); const bf16* KI = (const bf16*)(p.ws + WS_KIDX);
    const f32x2* CS = (const f32x2*)(p.ws + WS_CS);
    bf16* Y = (bf16*)(p.ws + WS_Y);
    unsigned* const SCRa = (unsigned*)(p.ws + WS_SCR) + (size_t)blockIdx.x * (16 * 4096); unsigned* const SCRb = (unsigned*)(p.ws + WS_SCR2) + (size_t)blockIdx.x * (16 * 4096);
    LAS unsigned char* wl = lds + wave * 10240;
    LAS int* sel = (LAS int*)(wl + 9216);
    const unsigned vbase = (unsigned)(size_t)wl;
    const int cx = blockIdx.x & 7, cj = blockIdx.x >> 3;
    constexpr int AQ_OFF = 8 * 10240;
#define AT_BLK(R) (255 - (AT_NA * (R) + (((R) & 1) ? (AT_NA - 1 - cj) : cj)))
#define AQ_PRODUCE(RR) do { const int _blk = AT_BLK(RR); \
        if (_blk >= 0 && (((16 * _blk) >> 6) + 1) * 64 > 256) { \
            int _l = lane0; asm volatile("" : "+v"(_l)); const int _fr = _l & 15, _fq = _l >> 4; const int _tok = cx * SEQ + 16 * _blk + _fr; \
            f32x2 _cs[8]; const f32x4* _csp = (const f32x4*)(CS + (size_t)_tok * 32 + 8 * _fq); \
            _Pragma("unroll") for (int _i = 0; _i < 4; ++_i) { const f32x4 _t = _csp[_i]; _cs[2 * _i] = (f32x2){_t.x, _t.y}; _cs[2 * _i + 1] = (f32x2){_t.z, _t.w}; } \
            const bf16* _src = PR + (size_t)_tok * NPROJ + C_QI + wave * 64 + 8 * _fq; \
            const u32x4 _lo = *(const u32x4*)_src, _hi = *(const u32x4*)(_src + 32); u32x4 _olo, _ohi; rope8(_lo, _hi, _cs, _olo, _ohi); \
            LAS unsigned char* _ab = lds + AQ_OFF + ((RR) & 1) * 16384 + _l * 16; \
            *(LAS u32x4*)(_ab + (2 * wave) * 1024) = _olo; *(LAS u32x4*)(_ab + (2 * wave + 1) * 1024) = _ohi; } } while (0)
    AQ_PRODUCE(0);
    asm volatile("s_waitcnt lgkmcnt(0)" ::: "memory");
    __syncthreads();
    for (int rr = 0; rr < 9; ++rr) {
        const int blk = AT_BLK(rr);
        if (blk < 0) break;
        unsigned* const SCR = (rr & 1) ? SCRb : SCRa;
        const int b = cx, tok0 = b * SEQ + 16 * blk;
        const int nadm = (((16 * blk) >> 6) + 1) << 6;
        const size_t kb0 = (size_t)b * SEQ;
        if (nadm > 256) {
            int lane = lane0; asm volatile("" : "+v"(lane)); const int fr = lane & 15, fq = lane >> 4;
            bf16x8 Aq[8][2];
            {
                const LAS unsigned char* ab = lds + AQ_OFF + (rr & 1) * 16384 + lane * 16;
#pragma unroll
                for (int h = 0; h < 8; ++h) { Aq[h][0] = *(const LAS bf16x8*)(ab + (2 * h) * 1024); Aq[h][1] = *(const LAS bf16x8*)(ab + (2 * h + 1) * 1024); }
            }
            float wq[4][8];
#pragma unroll
            for (int j = 0; j < 4; ++j) { const u32x4 t = *(const u32x4*)(PR + (size_t)(tok0 + 4 * fq + j) * NPROJ + C_WI);
                wq[j][0] = bflo(t.x) * 0.04419417382415922f; wq[j][1] = bfhi(t.x) * 0.04419417382415922f; wq[j][2] = bflo(t.y) * 0.04419417382415922f; wq[j][3] = bfhi(t.y) * 0.04419417382415922f;
                wq[j][4] = bflo(t.z) * 0.04419417382415922f; wq[j][5] = bfhi(t.z) * 0.04419417382415922f; wq[j][6] = bflo(t.w) * 0.04419417382415922f; wq[j][7] = bfhi(t.w) * 0.04419417382415922f; }
            const int nkt = nadm >> 4, ng = (nkt - wave + 7) >> 3;
            const bf16* kp = KI + (kb0 + 16 * wave + fr) * 64 + 8 * fq;
            bf16x8 rb[8][2];
#pragma unroll
            for (int i = 0; i < 8; ++i) asm volatile("" : "=v"(rb[i][0]), "=v"(rb[i][1]));
#define SC_TILE(i, kt) do { \
                    f32x4 sc = {0.f, 0.f, 0.f, 0.f}; f32x4 ah[8]; \
                    _Pragma("unroll") for (int h = 0; h < 8; ++h) ah[h] = __builtin_amdgcn_mfma_f32_16x16x32_bf16(Aq[h][0], rb[i][0], (f32x4){0.f, 0.f, 0.f, 0.f}, 0, 0, 0); \
                    _Pragma("unroll") for (int h = 0; h < 8; ++h) ah[h] = __builtin_amdgcn_mfma_f32_16x16x32_bf16(Aq[h][1], rb[i][1], ah[h], 0, 0, 0); \
                    _Pragma("unroll") for (int h = 0; h < 8; ++h) { const f32x4 acc = ah[h]; \
                        sc.x += wq[0][h] * relu_i(acc.x); sc.y += wq[1][h] * relu_i(acc.y); sc.z += wq[2][h] * relu_i(acc.z); sc.w += wq[3][h] * relu_i(acc.w); } \
                    if (sc.x == 0.f) sc.x = 0.f; if (sc.y == 0.f) sc.y = 0.f; if (sc.z == 0.f) sc.z = 0.f; if (sc.w == 0.f) sc.w = 0.f; \
                    scx = sc; } while (0)
#define SC_STORE(kt) do { unsigned* sp = SCR + (size_t)(4 * fq) * 4096 + 16 * (kt) + fr; \
                    sp[0] = sortkey(scx.x); sp[4096] = sortkey(scx.y); sp[2 * 4096] = sortkey(scx.z); sp[3 * 4096] = sortkey(scx.w); } while (0)
#define SC_ALOAD(i, ptr) asm volatile("global_load_dwordx4 %0, %2, off sc1\n\tglobal_load_dwordx4 %1, %2, off offset:64 sc1" : "=&v"(rb[i][0]), "=&v"(rb[i][1]) : "v"(ptr) : "memory")
#define SC_AWAIT(i, n) asm volatile("s_waitcnt vmcnt(" #n ")" : "+v"(rb[i][0]), "+v"(rb[i][1]) :: "memory")
            f32x4 scx;
            if (ng >= 16) {
#pragma unroll
                for (int i = 0; i < 8; ++i) { const bf16* q = kp + (size_t)i * 8192; SC_ALOAD(i, q); }
#define SC_FIRST(i, n) do { SC_AWAIT(i, n); SC_TILE(i, wave + 8 * (i)); { const bf16* q = kp + (size_t)(8 + (i)) * 8192; SC_ALOAD(i, q); } SC_STORE(wave + 8 * (i)); } while (0)
                SC_FIRST(0, 14); SC_FIRST(1, 18); SC_FIRST(2, 22); SC_FIRST(3, 26); SC_FIRST(4, 30); SC_FIRST(5, 34); SC_FIRST(6, 38); SC_FIRST(7, 42);
#undef SC_FIRST
                for (int g0 = 8; g0 < ng; g0 += 8) {
#pragma unroll
                    for (int i = 0; i < 8; ++i) if (g0 + i < ng) {
                        SC_AWAIT(i, 32);
                        SC_TILE(i, wave + 8 * (g0 + i));
                        if (g0 + 8 + i < ng) { const bf16* q = kp + (size_t)(g0 + 8 + i) * 8192; SC_ALOAD(i, q); }
                        SC_STORE(wave + 8 * (g0 + i));
                    }
                }
            } else {
#pragma unroll
                for (int i = 0; i < 8; ++i) if (i < ng) { rb[i][0] = *(const bf16x8*)(kp + (size_t)i * 8192); rb[i][1] = *(const bf16x8*)(kp + (size_t)i * 8192 + 32); }
                for (int g0 = 0; g0 < ng; g0 += 8) {
#pragma unroll
                    for (int i = 0; i < 8; ++i) if (g0 + i < ng) {
                        SC_TILE(i, wave + 8 * (g0 + i));
                        if (g0 + 8 + i < ng) { rb[i][0] = *(const bf16x8*)(kp + (size_t)(g0 + 8 + i) * 8192); rb[i][1] = *(const bf16x8*)(kp + (size_t)(g0 + 8 + i) * 8192 + 32); }
                        SC_STORE(wave + 8 * (g0 + i));
                    }
                }
            }
#undef SC_TILE
#undef SC_STORE
#undef SC_ALOAD
#undef SC_AWAIT
            AQ_PRODUCE(rr + 1);
            { const int tail = ((nadm + 511) & ~511) - nadm; for (int i = tid; i < 16 * tail; i += 512) SCR[(size_t)(i / tail) * 4096 + nadm + (i % tail)] = 0u; }
            asm volatile("s_waitcnt vmcnt(0) lgkmcnt(0)" ::: "memory");
        }
        __syncthreads();
        for (int qq = 0; qq < 2; ++qq) {
            const int qi = 2 * wave + qq, tok = tok0 + qi;
            int lane = lane0; asm volatile("" : "+v"(lane));
            int nvalid;
            if (nadm <= 256) { for (int s = lane; s < nadm; s += 64) sel[s] = s; nvalid = nadm; }
            else {
                unsigned K[64];
                const u32x4* sp = (const u32x4*)(SCR + (size_t)qi * 4096) + lane;
                {
                    u32x4 t[16];
#pragma unroll
                    for (int g = 0; g < 8; ++g) {
                        if (512 * g < nadm) {
#pragma unroll
                            for (int r4 = 0; r4 < 2; ++r4) { const u32x4* q = sp + 64 * (2 * g + r4); asm volatile("global_load_dwordx4 %0, %1, off sc1" : "=&v"(t[2 * g + r4]) : "v"(q) : "memory"); }
                        } else { t[2 * g] = (u32x4){0u, 0u, 0u, 0u}; t[2 * g + 1] = (u32x4){0u, 0u, 0u, 0u}; }
                    }
                    asm volatile("s_waitcnt vmcnt(0)" : "+v"(t[0]), "+v"(t[1]), "+v"(t[2]), "+v"(t[3]), "+v"(t[4]), "+v"(t[5]), "+v"(t[6]), "+v"(t[7]),
                                 "+v"(t[8]), "+v"(t[9]), "+v"(t[10]), "+v"(t[11]), "+v"(t[12]), "+v"(t[13]), "+v"(t[14]), "+v"(t[15]) :: "memory");
#pragma unroll
                    for (int i = 0; i < 16; ++i) { K[4 * i] = t[i].x; K[4 * i + 1] = t[i].y; K[4 * i + 2] = t[i].z; K[4 * i + 3] = t[i].w; }
                }
                unsigned prefix = 0u; int chi = 0, tge = nadm;
                for (int bit = 31; bit >= 18; --bit) {
                    const unsigned cand = prefix | (1u << bit); int cnt = 0;
#pragma unroll
                    for (int g = 0; g < 8; ++g) if (512 * g < nadm) {
                        cnt += cnt_ge8(K, g, cand);
                    }
                    if (cnt >= 256) { prefix = cand; tge = cnt; } else chi = cnt;
                }
                LAS unsigned* bl = (LAS unsigned*)wl;
                {
                    int bc = 0;
#pragma unroll
                    for (int g = 0; g < 8; ++g) if (512 * g < nadm) {
#pragma unroll
                        for (int r8 = 0; r8 < 8; ++r8) { const unsigned k = K[8 * g + r8]; const bool inb = (k - prefix) < 0x40000u;
                            if (__ballot(inb) != 0ull) { if (inb) { if (bc < 4) bl[bc * 64 + lane] = k; ++bc; } } }
                    }
                    if (__ballot(bc > 4) == 0ull) {
                        asm volatile("s_waitcnt lgkmcnt(0)" ::: "memory");
                        const unsigned B0 = (bc > 0) ? bl[lane] : 0u, B1 = (bc > 1) ? bl[64 + lane] : 0u, B2 = (bc > 2) ? bl[128 + lane] : 0u, B3 = (bc > 3) ? bl[192 + lane] : 0u;
                        for (int bit = 17; bit >= 0; --bit) {
                            const unsigned cand = prefix | (1u << bit);
                            const int cnt = chi + __popcll(__ballot(B0 >= cand)) + __popcll(__ballot(B1 >= cand)) + __popcll(__ballot(B2 >= cand)) + __popcll(__ballot(B3 >= cand));
                            if (cnt >= 256) { prefix = cand; tge = cnt; }
                        }
                    } else {
                        for (int bit = 17; bit >= 0; --bit) {
                            const unsigned cand = prefix | (1u << bit); int cnt = 0;
#pragma unroll
                            for (int g = 0; g < 8; ++g) if (512 * g < nadm) {
                                cnt += cnt_ge8(K, g, cand);
                            }
                            if (cnt >= 256) { prefix = cand; tge = cnt; }
                        }
                    }
                    asm volatile("s_waitcnt lgkmcnt(0)" ::: "memory");
                }
                bool done = false;
                if (tge == 256) {
                    int base = 0;
#pragma unroll
                    for (int g = 0; g < 8; ++g) if (512 * g < nadm) {
#pragma unroll
                        for (int r8 = 0; r8 < 8; ++r8) { const bool ge = K[8 * g + r8] >= prefix; const unsigned long long m = __ballot(ge);
                            if (ge) sel[base + (int)mbcnt64(m)] = 256 * ((8 * g + r8) >> 2) + 4 * lane + (r8 & 3);
                            base += __popcll(m); }
                    }
                    done = true;
                }
                if (!done) {
                int cgt = 0;
#pragma unroll
                for (int g = 0; g < 8; ++g) if (512 * g < nadm) {
#pragma unroll
                    for (int r8 = 0; r8 < 8; ++r8) cgt += __popcll(__ballot(K[8 * g + r8] > prefix));
                }
                const int need = 256 - cgt;
                int bgt = 0, beq = 0;
#pragma unroll
                for (int rr4 = 0; rr4 < 16; ++rr4) if (256 * rr4 < nadm) {
                    unsigned long long me[4]; int below = 0;
#pragma unroll
                    for (int i = 0; i < 4; ++i) { me[i] = __ballot(K[4 * rr4 + i] == prefix); below += (int)mbcnt64(me[i]); }
#pragma unroll
                    for (int i = 0; i < 4; ++i) { const int r = 4 * rr4 + i;
                        const bool gt = K[r] > prefix, eq = K[r] == prefix;
                        const unsigned long long mg = __ballot(gt);
                        const int pg = bgt + (int)mbcnt64(mg);
                        int same = 0;
#pragma unroll
                        for (int i2 = 0; i2 < 4; ++i2) if (i2 < i) same += (int)((me[i2] >> lane) & 1ull);
                        const int pe = beq + below + same;
                        if (gt) sel[pg] = 256 * rr4 + 4 * lane + i;
                        if (eq && pe < need) sel[cgt + pe] = 256 * rr4 + 4 * lane + i;
                        bgt += __popcll(mg); }
                    beq += __popcll(me[0]) + __popcll(me[1]) + __popcll(me[2]) + __popcll(me[3]);
                }
                }
                nvalid = 256;
            }
            asm volatile("s_waitcnt lgkmcnt(0)" ::: "memory");
            asm volatile("" : "+v"(lane)); const int fr = lane & 15, fq = lane >> 4;
            bf16x8 Bq0, Bq1;
            {
                f32x2 cs[8];
                const f32x4* csp = (const f32x4*)(CS + (size_t)tok * 32 + 8 * fq);
#pragma unroll
                for (int i = 0; i < 4; ++i) { const f32x4 t = csp[i]; cs[2 * i] = (f32x2){t.x, t.y}; cs[2 * i + 1] = (f32x2){t.z, t.w}; }
                const bf16* src = PR + (size_t)tok * NPROJ + C_Q + fr * 64 + 8 * fq;
                const u32x4 lo = *(const u32x4*)src, hi = *(const u32x4*)(src + 32);
                u32x4 olo, ohi; rope8(lo, hi, cs, olo, ohi);
                Bq0 = AS_BF8(olo); Bq1 = AS_BF8(ohi);
            }
            f32x4 S[16];
            {
                bf16x8 ka[16][2];
#pragma unroll
                for (int i = 0; i < 16; ++i) { int idx = sel[16 * i + fr]; idx = (16 * i + fr < nvalid) ? idx : 0; const bf16* kp = KB + (kb0 + idx) * 64 + 8 * fq; ka[i][0] = *(const bf16x8*)kp; ka[i][1] = *(const bf16x8*)(kp + 32); }
#pragma unroll
                for (int i = 0; i < 16; ++i) { f32x4 acc = {0.f, 0.f, 0.f, 0.f};
                    acc = __builtin_amdgcn_mfma_f32_16x16x32_bf16(ka[i][0], Bq0, acc, 0, 0, 0);
                    acc = __builtin_amdgcn_mfma_f32_16x16x32_bf16(ka[i][1], Bq1, acc, 0, 0, 0);
                    S[i] = acc; }
            }
            u32x4 va[8], vb[8], vc[8];
#define LOADV(dst, ch) do { _Pragma("unroll") for (int _i = 0; _i < 8; ++_i) { const int _sl = 64 * (ch) + 8 * _i + (lane >> 3); int _ix = sel[_sl]; _ix = (_sl < nvalid) ? _ix : 0; \
                dst[_i] = *(const u32x4*)(VB + (kb0 + _ix) * 64 + 8 * (lane & 7)); } } while (0)
            LOADV(va, 0); LOADV(vb, 1);
            const float SCL = 0.125f * 1.4426950408889634f;
            float mx = -INFINITY;
            if (nvalid < 256) {
#pragma unroll
                for (int t = 0; t < 16; ++t)
#pragma unroll
                    for (int j = 0; j < 4; ++j) S[t][j] = (16 * t + 4 * fq + j < nvalid) ? S[t][j] : -INFINITY;
            }
            f32x4 m4 = {-INFINITY, -INFINITY, -INFINITY, -INFINITY};
#pragma unroll
            for (int t = 0; t < 16; ++t) { const f32x4 v = S[t] * SCL; S[t] = v; m4.x = fmaxf(m4.x, v.x); m4.y = fmaxf(m4.y, v.y); m4.z = fmaxf(m4.z, v.z); m4.w = fmaxf(m4.w, v.w); }
            mx = fmaxf(mx, fmaxf(fmaxf(m4.x, m4.y), fmaxf(m4.z, m4.w)));
            mx = fmaxf(mx, __shfl_xor(mx, 16)); mx = fmaxf(mx, __shfl_xor(mx, 32));
            f32x4 s4 = {0.f, 0.f, 0.f, 0.f};
#pragma unroll
            for (int t = 0; t < 16; ++t) { const f32x4 d = S[t] - mx; const f32x4 e = {__builtin_amdgcn_exp2f(d.x), __builtin_amdgcn_exp2f(d.y), __builtin_amdgcn_exp2f(d.z), __builtin_amdgcn_exp2f(d.w)}; S[t] = e; s4 += e; }
            float sum = (s4.x + s4.y) + (s4.z + s4.w);
            sum += __shfl_xor(sum, 16); sum += __shfl_xor(sum, 32);
            const float inv = __builtin_amdgcn_rcpf(sum);
            bf16x8 Pk[8];
#pragma unroll
            for (int t2 = 0; t2 < 8; ++t2) { const f32x4 pa = S[2 * t2] * inv, pb = S[2 * t2 + 1] * inv; const u32x4 pw = {pk2(pa.x, pa.y), pk2(pa.z, pa.w), pk2(pb.x, pb.y), pk2(pb.z, pb.w)}; Pk[t2] = AS_BF8(pw); }
            f32x4 Oc[4];
#pragma unroll
            for (int c = 0; c < 4; ++c) Oc[c] = (f32x4){0.f, 0.f, 0.f, 0.f};
#define PVCHUNK(src, ch, NEXT) do { \
                _Pragma("unroll") for (int _i = 0; _i < 8; ++_i) *(LAS u32x4*)(wl + (8 * _i + (lane >> 3)) * 144 + 16 * (lane & 7)) = src[_i]; \
                NEXT; \
                asm volatile("s_waitcnt lgkmcnt(0)" ::: "memory"); \
                _Pragma("unroll") for (int tl = 0; tl < 2; ++tl) { \
                    const bf16x8 Ap = Pk[2 * (ch) + tl]; \
                    const unsigned r0 = vbase + (unsigned)((32 * tl + 4 * fq + ((lane & 15) >> 2)) * 144 + 8 * (lane & 3)), r1 = r0 + 16 * 144; \
                    u32x2 x0[4], x1[4]; ds_read_tr16x8(r0, r1, x0, x1); \
                    _Pragma("unroll") for (int c = 0; c < 4; ++c) { const u32x4 bw = {x0[c].x, x0[c].y, x1[c].x, x1[c].y}; \
                        Oc[c] = __builtin_amdgcn_mfma_f32_16x16x32_bf16(AS_BF8(bw), Ap, Oc[c], 0, 0, 0); } \
                } \
                asm volatile("s_waitcnt lgkmcnt(0)" ::: "memory"); } while (0)
            LOADV(vc, 2);
            PVCHUNK(va, 0, LOADV(va, 3));
            PVCHUNK(vb, 1, (void)0);
            PVCHUNK(vc, 2, (void)0);
            PVCHUNK(va, 3, (void)0);
#undef PVCHUNK
#undef LOADV
            float ss = 0.f;
#pragma unroll
            for (int c = 0; c < 4; ++c) ss += Oc[c].x * Oc[c].x + Oc[c].y * Oc[c].y + Oc[c].z * Oc[c].z + Oc[c].w * Oc[c].w;
            const float rs = (1.f / sqrtf(wave_sum(ss) * (1.f / 1024.f) + EPS)) / ((const float*)(p.ws + WS_SSQ))[tok];
#pragma unroll
            for (int c = 0; c < 4; ++c) { int q8 = __builtin_amdgcn_cvt_pk_fp8_f32(Oc[c].x * rs, Oc[c].y * rs, 0, false); q8 = __builtin_amdgcn_cvt_pk_fp8_f32(Oc[c].z * rs, Oc[c].w * rs, q8, true);
                *(unsigned*)((unsigned char*)(p.ws + WS_Y8) + (size_t)tok * DM + 1024 + fr * 64 + 16 * c + 4 * fq) = (unsigned)q8; }
        }
    }
}

constexpr int RT_STRIDE = 4112;
__device__ __forceinline__ void ph_route(const P& p, LAS unsigned char* lds) {
    const int tid = otid(), lane = tid & 63, wave = __builtin_amdgcn_readfirstlane(tid >> 6), fr = lane & 15, fq = lane >> 4;
    const float* mod = (const float*)(p.ws + WS_MOD);
    bf16* H = (bf16*)(p.ws + WS_H); const bf16* WR = (const bf16*)(p.ws + WS_WR);
    unsigned* cnt = (unsigned*)(p.ws + WS_CTL) + CW_CNT;
    int* list = (int*)(p.ws + WS_LIST); u32x4* tokinfo = (u32x4*)(p.ws + WS_TOK);
    LAS unsigned char* img = lds;
    LAS float* part = (LAS float*)(lds + 16 * RT_STRIDE);
    LAS float* logit = part + 8 * 16 * 48;
    LAS unsigned* lcnt = (LAS unsigned*)(logit + 16 * 48);
    LAS u32x4* rinfo = (LAS u32x4*)(lcnt + 64);
    const int ngrp = NT / 16, gpw = (ngrp + gridDim.x - 1) / gridDim.x;
    const int g_lo = blockIdx.x * gpw, g_hi = (g_lo + gpw < ngrp) ? g_lo + gpw : ngrp;
    if (tid < 32) lcnt[tid] = 0u;
    __syncthreads();
    f32x4 gsc[8], shv[8];
    { const int b = (g_lo * 16) >> 12;
#pragma unroll
      for (int j = 0; j < 8; ++j) { const int col = 4 * lane + 256 * j;
          const f32x4 g = *(const f32x4*)(p.norm2_g + col), sh = *(const f32x4*)(mod + b * 12288 + 3 * 2048 + col), sc = *(const f32x4*)(mod + b * 12288 + 4 * 2048 + col);
          gsc[j] = g * (sc + 1.f); shv[j] = sh; } }
    u32x2 xt[2][8];
#define RT_LOADX(G) do { _Pragma("unroll") for (int rr = 0; rr < 2; ++rr) { const u32x2* xr = (const u32x2*)((const bf16*)(p.ws + WS_X1) + (size_t)((G) * 16 + 2 * wave + rr) * DM) + lane; \
        _Pragma("unroll") for (int j = 0; j < 8; ++j) xt[rr][j] = __builtin_nontemporal_load(xr + 64 * j); } } while (0)
    if (g_lo < g_hi) RT_LOADX(g_lo);
    for (int grp = g_lo; grp < g_hi; ++grp) {
#pragma unroll
        for (int rr = 0; rr < 2; ++rr) {
            const int lr = 2 * wave + rr, m = grp * 16 + lr;
            f32x4 v[8]; float ss = 0.f;
#pragma unroll
            for (int j = 0; j < 8; ++j) { const u32x2 t = xt[rr][j]; v[j] = (f32x4){bflo(t.x), bfhi(t.x), bflo(t.y), bfhi(t.y)}; ss += v[j].x * v[j].x + v[j].y * v[j].y + v[j].z * v[j].z + v[j].w * v[j].w; }
            const float rstd = 1.f / sqrtf(wave_sum(ss) * (1.f / DM) + EPS);
            unsigned* o = (unsigned*)((unsigned char*)H + (size_t)m * DM) + lane;
#pragma unroll
            for (int j = 0; j < 8; ++j) {
                const int col = 4 * lane + 256 * j;
                const f32x4 h = v[j] * rstd * gsc[j] + shv[j];
                const u32x2 w = {pk2(h.x, h.y), pk2(h.z, h.w)};
                { int q8 = __builtin_amdgcn_cvt_pk_fp8_f32(h.x, h.y, 0, false); q8 = __builtin_amdgcn_cvt_pk_fp8_f32(h.z, h.w, q8, true); o[64 * j] = (unsigned)q8; }
                *(LAS u32x2*)(img + lr * RT_STRIDE + col * 2) = w;
            }
        }
        if (grp + 1 < g_hi) RT_LOADX(grp + 1);
        __syncthreads();
        {
            f32x4 acc[3];
#pragma unroll
            for (int n = 0; n < 3; ++n) acc[n] = (f32x4){0.f, 0.f, 0.f, 0.f};
#pragma unroll
            for (int s8 = 0; s8 < 8; ++s8) {
                const int k0 = 256 * wave + 32 * s8 + 8 * fq;
                const bf16x8 a = *(const LAS bf16x8*)(img + fr * RT_STRIDE + k0 * 2);
#pragma unroll
                for (int n = 0; n < 3; ++n) { const bf16x8 bw = *(const bf16x8*)(WR + (size_t)(16 * n + fr) * DM + k0);
                    acc[n] = __builtin_amdgcn_mfma_f32_16x16x32_bf16(a, bw, acc[n], 0, 0, 0); }
            }
#pragma unroll
            for (int n = 0; n < 3; ++n)
#pragma unroll
                for (int j = 0; j < 4; ++j) part[(wave * 16 + 4 * fq + j) * 48 + 16 * n + fr] = acc[n][j];
        }
        __syncthreads();
        for (int i = tid; i < 16 * 48; i += 512) { float sacc = 0.f;
#pragma unroll
            for (int w = 0; w < 8; ++w) sacc += part[w * 768 + i];
            const int col = i % 48; sacc += (col < 4) ? p.b_group[col] : ((col < 36) ? p.b_expert[col - 4] : 0.f);
            logit[i] = sacc; }
        __syncthreads();
        if (tid < 16) {
            const LAS float* lg = logit + tid * 48;
            int gi = 0; float gm = lg[0];
#pragma unroll
            for (int q = 1; q < 4; ++q) { const float t = lg[q]; if (t > gm) { gm = t; gi = q; } }
            float gs = 0.f;
#pragma unroll
            for (int q = 0; q < 4; ++q) gs += expf(lg[q] - gm);
            const float gp = 1.f / gs;
            const LAS float* el = lg + 4 + 8 * gi;
            int i1 = 0; float m1 = el[0];
#pragma unroll
            for (int q = 1; q < 8; ++q) { const float t = el[q]; if (t > m1) { m1 = t; i1 = q; } }
            int i2 = -1; float m2 = -INFINITY;
#pragma unroll
            for (int q = 0; q < 8; ++q) { const float t = el[q]; if (q != i1 && t > m2) { m2 = t; i2 = q; } }
            const float r2 = expf(m2 - m1);
            const float w0 = gp / (1.f + r2), w1 = gp * r2 / (1.f + r2);
            const int e0 = gi * 8 + i1, e1 = gi * 8 + i2;
            const unsigned p0 = __hip_atomic_fetch_add(&lcnt[e0], 1u, __ATOMIC_RELAXED, __HIP_MEMORY_SCOPE_WORKGROUP), p1 = __hip_atomic_fetch_add(&lcnt[e1], 1u, __ATOMIC_RELAXED, __HIP_MEMORY_SCOPE_WORKGROUP);
            rinfo[(grp - g_lo) * 16 + tid] = (u32x4){((unsigned)e0 << 16) | p0, ((unsigned)e1 << 16) | p1, __float_as_uint(w0), __float_as_uint(w1)};
        }
        __syncthreads();
    }
    if (tid < 32) { const unsigned c = lcnt[tid]; lcnt[tid] = c ? atomicAdd(&cnt[tid], c) : 0u; }
    __syncthreads();
    for (int r = tid; r < (g_hi - g_lo) * 16; r += 512) {
        const u32x4 ri = rinfo[r]; const int m = g_lo * 16 + r;
        const unsigned e0 = ri.x >> 16, e1 = ri.y >> 16;
        const unsigned p0 = lcnt[e0] + (ri.x & 0xffffu), p1 = lcnt[e1] + (ri.y & 0xffffu);
        list[(size_t)e0 * NT + p0] = m; list[(size_t)e1 * NT + p1] = m;
        tokinfo[m] = (u32x4){(e0 << 16) | p0, (e1 << 16) | p1, ri.z, ri.w};
    }
}

#undef RT_LOADX
__device__ __forceinline__ void ph_final(const P& p) {
    const int tid = otid(), lane = tid & 63, wave = tid >> 6;
    const int gw = blockIdx.x * 8 + wave, NGW = gridDim.x * 8;
    const unsigned* cnt = (const unsigned*)(p.ws + WS_CTL) + CW_CNT;
    const u32x4* tokinfo = (const u32x4*)(p.ws + WS_TOK); const bf16* YM = (const bf16*)(p.ws + WS_YMOE); const float* mod = (const float*)(p.ws + WS_MOD);
    int myb = 0;
    { int run = 0; for (int e = 0; e < NE; ++e) { if (lane == e) myb = run; run += ((int)cnt[e] + 255) & ~255; } }
    for (int m0 = 2 * gw; m0 < NT; m0 += 2 * NGW) {
        u32x2 xt[2][8]; unsigned ya[2][8], yb[2][8]; float w0[2], w1[2];
#pragma unroll
        for (int r = 0; r < 2; ++r) {
            const int m = m0 + r;
            const u32x4 ti = tokinfo[m];
            const int e0 = ti.x >> 16, p0 = ti.x & 0xffff, e1 = ti.y >> 16, p1 = ti.y & 0xffff;
            const unsigned w0b = ti.z, w1b = ti.w;
            w0[r] = __uint_as_float(w0b); w1[r] = __uint_as_float(w1b);
            const size_t r0 = (size_t)(__shfl(myb, e0) + p0), r1 = (size_t)(__shfl(myb, e1) + p1);
            const u32x2* x1r = (const u32x2*)((const bf16*)(p.ws + WS_X1) + (size_t)m * DM) + lane;
            const unsigned* y0 = (const unsigned*)((const unsigned char*)YM + r0 * DM) + lane; const unsigned* y1 = (const unsigned*)((const unsigned char*)YM + r1 * DM) + lane;
#pragma unroll
            for (int j = 0; j < 8; ++j) { xt[r][j] = x1r[64 * j]; ya[r][j] = y0[64 * j]; yb[r][j] = y1[64 * j]; }
        }
#pragma unroll
        for (int r = 0; r < 2; ++r) {
            const int m = m0 + r, b = m >> 12;
            f32x4* xr = (f32x4*)(p.out + (size_t)m * DM) + lane;
            f32x4 v[8]; float ss = 0.f;
#pragma unroll
            for (int j = 0; j < 8; ++j) {
                const int col = 4 * lane + 256 * j;
                const f32x4 xv = {bflo(xt[r][j].x), bfhi(xt[r][j].x), bflo(xt[r][j].y), bfhi(xt[r][j].y)};
                const unsigned a = ya[r][j], c = yb[r][j];
                const f32x4 g2 = *(const f32x4*)(mod + b * 12288 + 5 * 2048 + col);
                const f32x2 a01 = __builtin_amdgcn_cvt_pk_f32_fp8((int)a, false), a23 = __builtin_amdgcn_cvt_pk_f32_fp8((int)a, true), c01 = __builtin_amdgcn_cvt_pk_f32_fp8((int)c, false), c23 = __builtin_amdgcn_cvt_pk_f32_fp8((int)c, true);
                const f32x4 yav = (f32x4){a01.x, a01.y, a23.x, a23.y} * 0.0625f, ybv = (f32x4){c01.x, c01.y, c23.x, c23.y} * 0.0625f;
                v[j] = xv + g2 * (yav * w0[r] + ybv * w1[r]);
                ss += v[j].x * v[j].x + v[j].y * v[j].y + v[j].z * v[j].z + v[j].w * v[j].w;
            }
            const float rstd = 1.f / sqrtf(wave_sum(ss) * (1.f / DM) + EPS);
#pragma unroll
            for (int j = 0; j < 8; ++j) { const int col = 4 * lane + 256 * j; __builtin_nontemporal_store(v[j] * rstd * *(const f32x4*)(p.final_g + col), xr + 64 * j); }
        }
    }
}


__global__ void __launch_bounds__(512, 2) mk_fwd(P p) {
    extern __shared__ __attribute__((aligned(16))) unsigned char lds_raw[];
    LAS unsigned char* lds = (LAS unsigned char*)lds_raw;
    const int lo = p.ph_lo, hi = p.ph_hi;
#ifdef PHSEL
#define IN(k) ((k)==PHSEL && lo <= (k) && (k) < hi)
#else
#define IN(k) (lo <= (k) && (k) < hi)
#endif
#define BOTH(k) (IN(k) && IN((k) + 1))
    if (threadIdx.x < 16) ((LAS unsigned*)(lds + LDS_MISC))[threadIdx.x] = 0u;
    __syncthreads();
    XcdBarrier bar = xcd_barrier_post((unsigned*)(p.ws + WS_CTL) + CW_BAR, (volatile LAS unsigned*)(lds + LDS_MISC));
    if (IN(0)) { ph_prep_ada(p, lds); if (BOTH(0)) xcd_barrier(bar); }
    if (IN(1)) { if (blockIdx.x & 1) { ph_prep(p, lds); ph_h(p); } else { ph_h(p); ph_prep(p, lds); }
                 if (BOTH(1)) xcd_barrier(bar); }
    if (IN(2)) { ph_inproj(p, lds); if (BOTH(2)) xcd_barrier(bar); }
    if (IN(3)) { ph_gmlp_kv(p, lds); if (BOTH(3)) xcd_barrier(bar); }
    if (IN(4)) { ph_attn(p, lds); if (IN(6)) xcd_barrier(bar); }
    if (IN(6)) { if (blockIdx.x & 1) ph_convert_chunk(p, lds, 256 + (int)blockIdx.x); ph_outproj(p, lds); if (!(blockIdx.x & 1)) ph_convert_chunk(p, lds, 256 + (int)blockIdx.x); if (BOTH(6)) xcd_barrier(bar); }
    if (IN(7)) { if (blockIdx.x & 1) { ph_route(p, lds); __syncthreads(); ph_prep_experts(p, lds); } else { ph_prep_experts(p, lds); __syncthreads(); ph_route(p, lds); }
                 if (BOTH(7)) xcd_barrier(bar); }
    if (IN(8)) { ph_moe1(p, lds); if (BOTH(8)) xcd_barrier(bar); }
    if (IN(9)) { ph_moe2(p, lds); if (BOTH(9)) xcd_barrier(bar); }
    if (IN(10)) ph_final(p);
#undef BOTH
#undef IN
}

extern "C" void kernel_launch(void* const* d_in, const int* in_sizes, int n_in, void* d_out, int out_size, void* d_ws, size_t ws_size, hipStream_t stream) {
    static int grid = 0;
    if (grid == 0) {
        if (n_in != 27 || out_size != NT * DM || ws_size < WS_END) { fprintf(stderr, "kernel_launch: unexpected shapes n_in %d out %d ws %zu\n", n_in, out_size, ws_size); grid = -1; return; }
        int dev = 0, cus = 0;
        if (hipGetDevice(&dev) != hipSuccess || hipDeviceGetAttribute(&cus, hipDeviceAttributeMultiprocessorCount, dev) != hipSuccess) { grid = -1; return; }
        if (hipFuncSetAttribute((const void*)mk_fwd, hipFuncAttributeMaxDynamicSharedMemorySize, LDS_BYTES) != hipSuccess) { fprintf(stderr, "kernel_launch: hipFuncSetAttribute failed\n"); grid = -1; return; }
        grid = 256;
        if (cus != 256) fprintf(stderr, "kernel_launch: %d CUs reported; this kernel is built for a 256-CU device\n", cus);
    }
    if (grid < 0) return;
    (void)hipMemsetAsync((char*)d_ws + WS_CTL, 0, CTL_BYTES, stream);
    P p{};
    p.x = (const float*)d_in[0]; p.c = (const float*)d_in[1]; p.pos = (const int*)d_in[2];
    p.w_ada = (const float*)d_in[3]; p.b_ada = (const float*)d_in[4]; p.norm1_g = (const float*)d_in[5]; p.w_in = (const float*)d_in[6];
    p.v_norm_g = (const float*)d_in[7]; p.v_norm_b = (const float*)d_in[8]; p.w_sp = (const float*)d_in[9]; p.b_sp = (const float*)d_in[10];
    p.kv_norm_g = (const float*)d_in[11]; p.w_uk = (const float*)d_in[12]; p.w_uv = (const float*)d_in[13]; p.kidx_norm_g = (const float*)d_in[14];
    p.gnorm_a_g = (const float*)d_in[15]; p.gnorm_b_g = (const float*)d_in[16]; p.w_out = (const float*)d_in[17]; p.norm2_g = (const float*)d_in[18];
    p.w_group = (const float*)d_in[19]; p.b_group = (const float*)d_in[20]; p.w_expert = (const float*)d_in[21]; p.b_expert = (const float*)d_in[22];
    p.w1 = (const float*)d_in[23]; p.w3 = (const float*)d_in[24]; p.w2 = (const float*)d_in[25]; p.final_g = (const float*)d_in[26];
    p.out = (float*)d_out; p.ws = (unsigned char*)d_ws;
    for (int i = 0; i < 32; ++i) p.freqs[i] = (float)pow(10000.0, -(double)i / 32.0);
    p.ph_lo = 0; p.ph_hi = 11;
    hipLaunchKernelGGL(mk_fwd, dim3(grid), dim3(512), LDS_BYTES, stream, p);
}
```

```cpp
#include <hip/hip_runtime.h>
#include <cstdio>
#include <cstdint>
#include <cmath>

#define LAS __attribute__((address_space(3)))
typedef unsigned short bf16;
typedef short bf16x8 __attribute__((ext_vector_type(8)));
typedef float f32x4 __attribute__((ext_vector_type(4)));
typedef float f32x2 __attribute__((ext_vector_type(2)));
typedef unsigned u32x4 __attribute__((ext_vector_type(4)));
typedef unsigned u32x2 __attribute__((ext_vector_type(2)));

constexpr int NB = 8, SEQ = 4096, DM = 2048, NT = NB * SEQ;
constexpr int NPROJ = 4096, INC = 3912;
constexpr int C_U = 0, C_V = 1024, C_Q = 2048, C_CKV = 3072, C_QI = 3328, C_KI = 3840, C_WI = 3904;
constexpr int NE = 32, DE = 1024;
constexpr int SLOT_ROWS = 65536 + 32 * 256;
constexpr float EPS = 1e-6f;
constexpr int NPH = 12;

constexpr size_t MiB = 1u << 20;
constexpr size_t WS_CTL = 0, CTL_BYTES = 1 * MiB;
constexpr size_t WS_MOD = 1 * MiB;
constexpr size_t WS_CS = 2 * MiB;
constexpr size_t WS_WIN = 10 * MiB;
constexpr size_t WS_WOUT = 26 * MiB;
constexpr size_t WS_WSP = 34 * MiB;
constexpr size_t WS_WUKV = 34 * MiB + 256 * 1024;
constexpr size_t WS_WR = 34 * MiB + 512 * 1024;
constexpr size_t WS_KB = 35 * MiB, WS_VB = 39 * MiB, WS_KIDX = 43 * MiB;
constexpr size_t WS_SSQ = 47 * MiB;
constexpr size_t WS_LIST = 48 * MiB;
constexpr size_t WS_TOK = 52 * MiB;
constexpr size_t WS_W13 = 56 * MiB;
constexpr size_t WS_W2 = 312 * MiB;
constexpr size_t WS_PROJ = 440 * MiB;
constexpr size_t WS_H = 696 * MiB;
constexpr size_t WS_Y = 824 * MiB;
constexpr size_t WS_ACT = WS_PROJ;
constexpr size_t WS_YMOE = 584 * MiB;
constexpr size_t WS_SCR = 952 * MiB;
constexpr size_t WS_SCR2 = 248 * MiB;
constexpr size_t WS_H8 = 184 * MiB;
constexpr size_t WS_WIN8 = 376 * MiB;
constexpr size_t WS_X1 = 1016 * MiB;
constexpr size_t WS_Y8 = WS_H;
constexpr size_t WS_END = 1144 * MiB;
constexpr int CW_BAR = 4096, CW_CNT = 16384;

constexpr int LDS_BYTES = 163840 - 512;
constexpr int LDS_MISC = LDS_BYTES - 64;

struct P {
    const float *x, *c; const int* pos;
    const float *w_ada, *b_ada, *norm1_g, *w_in, *v_norm_g, *v_norm_b, *w_sp, *b_sp, *kv_norm_g, *w_uk, *w_uv, *kidx_norm_g, *gnorm_a_g, *gnorm_b_g, *w_out, *norm2_g,
        *w_group, *b_group, *w_expert, *b_expert, *w1, *w3, *w2, *final_g;
    float* out; unsigned char* ws;
    int ph_lo, ph_hi;
    float freqs[32];
};

__device__ __forceinline__ int otid() { int t = threadIdx.x; asm volatile("" : "+v"(t)); return t; }
__device__ __forceinline__ unsigned f2bf(float f) { unsigned u = __builtin_bit_cast(unsigned, f); return (u + 0x7fffu + ((u >> 16) & 1u)) >> 16; }
typedef __bf16 hwbf16x2 __attribute__((ext_vector_type(2)));
typedef float hwf32x2 __attribute__((ext_vector_type(2)));
__device__ __forceinline__ unsigned pk2(float lo, float hi) { const hwf32x2 v = {lo, hi}; return __builtin_bit_cast(unsigned, __builtin_convertvector(v, hwbf16x2)); }
__device__ __forceinline__ float bflo(unsigned w) { return __builtin_bit_cast(float, w << 16); }
__device__ __forceinline__ float bfhi(unsigned w) { return __builtin_bit_cast(float, w & 0xffff0000u); }
__device__ __forceinline__ float bf2f(bf16 b) { return __builtin_bit_cast(float, ((unsigned)b) << 16); }
template <int CTRL> __device__ __forceinline__ float dpp_f(float v) { return __int_as_float(__builtin_amdgcn_update_dpp(0, __float_as_int(v), CTRL, 0xf, 0xf, false)); }
__device__ __forceinline__ float row16_sum(float v) { v += dpp_f<0x128>(v); v += dpp_f<0x124>(v); v += dpp_f<0x122>(v); v += dpp_f<0x121>(v); return v; }
__device__ __forceinline__ float row16_max(float v) { v = fmaxf(v, dpp_f<0x128>(v)); v = fmaxf(v, dpp_f<0x124>(v)); v = fmaxf(v, dpp_f<0x122>(v)); v = fmaxf(v, dpp_f<0x121>(v)); return v; }
__device__ __forceinline__ float wave_sum(float v) { v = row16_sum(v); v += __shfl_xor(v, 16); v += __shfl_xor(v, 32); return v; }
__device__ __forceinline__ float wave_max(float v) { v = row16_max(v); v = fmaxf(v, __shfl_xor(v, 16)); v = fmaxf(v, __shfl_xor(v, 32)); return v; }
__device__ __forceinline__ float gelu_tanh(float x) {
    const float t = x * (2.3022082f + 0.10294324f * x * x);
    const float e = __builtin_amdgcn_exp2f(t);
    return __builtin_fmaf(-x, __builtin_amdgcn_rcpf(1.f + e), x);
}
__device__ __forceinline__ float relu_i(float x) { const int b = __float_as_int(x); return __int_as_float(b > 0 ? b : 0); }
__device__ __forceinline__ float silu_f(float x) { return x * __builtin_amdgcn_rcpf(1.f + __expf(-x)); }
__device__ __forceinline__ void sincos_acc(float angf, float& s, float& c) {
    const double x = (double)angf;
    const double kd = rint(x * 0.6366197723675814);
    double r = fma(-kd, 1.5707963267948966, x);
    r = fma(-kd, 6.123233995736766e-17, r);
    const int q = (int)((long long)kd & 3);
    const double r2 = r * r;
    const double sp = r * (1.0 + r2 * (-1.0 / 6 + r2 * (1.0 / 120 + r2 * (-1.0 / 5040 + r2 * (1.0 / 362880 + r2 * (-1.0 / 39916800 + r2 * (1.0 / 6227020800.0)))))));
    const double cp = 1.0 + r2 * (-0.5 + r2 * (1.0 / 24 + r2 * (-1.0 / 720 + r2 * (1.0 / 40320 + r2 * (-1.0 / 3628800 + r2 * (1.0 / 479001600 + r2 * (-1.0 / 87178291200.0)))))));
    double ss, cc;
    if (q == 0) { ss = sp; cc = cp; } else if (q == 1) { ss = cp; cc = -sp; } else if (q == 2) { ss = -sp; cc = -cp; } else { ss = -cp; cc = sp; }
    s = (float)ss; c = (float)cc;
}


#define XB_TMO      128
#define XB_XCNT(j)  (256  + 64 * (j))
#define XB_XSUB(j)  (1280 + 64 * (j))
#define XB_XGEN(j)  (2304 + 64 * (j))
#define XB_TOP      3328
#define XB_TOPGEN   3392
#define XCD_BAR_WORDS 3456
#define XB_SPIN_CAP (1u << 18)
__device__ __forceinline__ unsigned xb_ld(unsigned* p)              { return __hip_atomic_load(p, __ATOMIC_RELAXED, __HIP_MEMORY_SCOPE_AGENT); }
__device__ __forceinline__ unsigned xb_add(unsigned* p, unsigned v) { return __hip_atomic_fetch_add(p, v, __ATOMIC_RELAXED, __HIP_MEMORY_SCOPE_AGENT); }
__device__ __forceinline__ unsigned xb_xcc_id() { return (unsigned)__builtin_amdgcn_s_getreg((3 << 11) | 20) & 0xFu; }
#define XB_SPIN(cond, bar) do { unsigned _sp = 0; while (cond) { __builtin_amdgcn_s_sleep(1); \
    if ((++_sp & 255u) == 0u) { if (xb_ld(&(bar)[XB_TMO])) break; if (_sp > XB_SPIN_CAP) { atomicAdd(&(bar)[XB_TMO], 1u); break; } } } } while (0)
struct XcdBarrier { unsigned* bar; unsigned x; volatile LAS unsigned* st; };
__device__ __forceinline__ XcdBarrier xcd_barrier_post(unsigned* bar, volatile LAS unsigned* st) {
    XcdBarrier b; b.bar = bar; b.x = xb_xcc_id(); b.st = st;
    if (threadIdx.x == 0) (void)xb_add(&bar[XB_XCNT(b.x)], 1u);
    return b;
}
__device__ __forceinline__ void xcd_barrier_complete(unsigned* bar, unsigned x, unsigned& nloc, unsigned& nx) {
    const unsigned G = gridDim.x * gridDim.y * gridDim.z;
    unsigned sum, cnt, mine, sp = 0u;
    for (;;) {
        sum = 0u; cnt = 0u; mine = 0u;
#pragma unroll
        for (unsigned j = 0; j < 16; ++j) { const unsigned c = xb_ld(&bar[XB_XCNT(j)]); sum += c; cnt += (c > 0u) ? 1u : 0u; mine = (j == x) ? c : mine; }
        if (sum == G) break;
        __builtin_amdgcn_s_sleep(1);
        if ((++sp & 255u) == 0u) { if (xb_ld(&bar[XB_TMO])) break; if (sp > XB_SPIN_CAP) { atomicAdd(&bar[XB_TMO], 1u); break; } }
    }
    nloc = mine > 0u ? mine : 1u; nx = cnt > 0u ? cnt : 1u;
}
__device__ __forceinline__ void xcd_barrier(const XcdBarrier& b) {
    asm volatile("s_waitcnt vmcnt(0)" ::: "memory");
    __syncthreads();
    if (threadIdx.x == 0) {
        unsigned* bar = b.bar;
        __builtin_amdgcn_s_waitcnt(0);
        unsigned nloc = b.st[0], nx = b.st[1];
        if (nloc == 0u) { xcd_barrier_complete(bar, b.x, nloc, nx); b.st[0] = nloc; b.st[1] = nx; }
        const unsigned old = xb_add(&bar[XB_XSUB(b.x)], 1u);
        const unsigned gen = old / nloc;
        if (old + 1u == (gen + 1u) * nloc) {
            __builtin_amdgcn_fence(__ATOMIC_RELEASE, "agent");
            asm volatile("s_waitcnt vmcnt(0)" ::: "memory");
            const unsigned og = xb_add(&bar[XB_TOP], 1u);
            const unsigned tg = og / nx;
            if (og + 1u == (tg + 1u) * nx) xb_add(&bar[XB_TOPGEN], 1u);
            else XB_SPIN(xb_ld(&bar[XB_TOPGEN]) == tg, bar);
            __builtin_amdgcn_fence(__ATOMIC_ACQUIRE, "agent");
            xb_add(&bar[XB_XGEN(b.x)], 1u);
            asm volatile("s_waitcnt vmcnt(0)" ::: "memory");
        } else {
            XB_SPIN(xb_ld(&bar[XB_XGEN(b.x)]) == gen, bar);
            __builtin_amdgcn_fence(__ATOMIC_ACQUIRE, "agent");
            asm volatile("s_waitcnt vmcnt(0)" ::: "memory");
        }
    }
    __syncthreads();
}

__device__ __forceinline__ void tr_item(const float* src, int ld, int nvalid, int k0, int n0, bf16* dst_n0, int ldd, const float* kscale, LAS float* scr, int lane) {
    float lv[32];
#pragma unroll
    for (int i = 0; i < 32; ++i) { const int kk = 2 * i + (lane >> 5), n = n0 + (lane & 31); lv[i] = (n < nvalid) ? __builtin_nontemporal_load(src + (size_t)(k0 + kk) * ld + n) : 0.f; }
#pragma unroll
    for (int i = 0; i < 32; ++i) {
        const int kk = 2 * i + (lane >> 5);
        float v = lv[i];
        if (kscale) v *= kscale[k0 + kk];
        scr[kk * 33 + (lane & 31)] = v;
    }
    asm volatile("s_waitcnt lgkmcnt(0)" ::: "memory");
    const int c = lane & 7;
#pragma unroll
    for (int j = 0; j < 4; ++j) {
        const int n = (lane >> 3) + 8 * j; const LAS float* s = scr + (8 * c) * 33 + n;
        u32x4 o; o.x = pk2(s[0 * 33], s[1 * 33]); o.y = pk2(s[2 * 33], s[3 * 33]); o.z = pk2(s[4 * 33], s[5 * 33]); o.w = pk2(s[6 * 33], s[7 * 33]);
        *(u32x4*)(dst_n0 + (size_t)n * ldd + k0 + 8 * c) = o;
    }
    asm volatile("s_waitcnt lgkmcnt(0)" ::: "memory");
}

__device__ __forceinline__ void tr_item_fp8(const float* src, int ld, int k0, int n0, unsigned char* dst_n0, int ldd, float sc, LAS float* scr, int lane, const float* kscale = nullptr) {
    f32x4 ld4[8];
#pragma unroll
    for (int i = 0; i < 8; ++i) ld4[i] = __builtin_nontemporal_load((const f32x4*)(src + (size_t)(k0 + 8 * i + (lane >> 3)) * ld + n0 + 4 * (lane & 7)));
#pragma unroll
    for (int i = 0; i < 8; ++i) { const int kk = 8 * i + (lane >> 3); float m = sc; if (kscale) m *= kscale[k0 + kk]; LAS float* q = scr + kk * 33 + 4 * (lane & 7);
        q[0] = ld4[i].x * m; q[1] = ld4[i].y * m; q[2] = ld4[i].z * m; q[3] = ld4[i].w * m; }
    asm volatile("s_waitcnt lgkmcnt(0)" ::: "memory");
    const int c = lane & 3;
#pragma unroll
    for (int j = 0; j < 2; ++j) {
        const int n = (lane >> 2) + 16 * j; const LAS float* q = scr + (16 * c) * 33 + n;
        u32x4 o; int w;
        w = __builtin_amdgcn_cvt_pk_fp8_f32(q[0 * 33], q[1 * 33], 0, false); w = __builtin_amdgcn_cvt_pk_fp8_f32(q[2 * 33], q[3 * 33], w, true); o.x = (unsigned)w;
        w = __builtin_amdgcn_cvt_pk_fp8_f32(q[4 * 33], q[5 * 33], 0, false); w = __builtin_amdgcn_cvt_pk_fp8_f32(q[6 * 33], q[7 * 33], w, true); o.y = (unsigned)w;
        w = __builtin_amdgcn_cvt_pk_fp8_f32(q[8 * 33], q[9 * 33], 0, false); w = __builtin_amdgcn_cvt_pk_fp8_f32(q[10 * 33], q[11 * 33], w, true); o.z = (unsigned)w;
        w = __builtin_amdgcn_cvt_pk_fp8_f32(q[12 * 33], q[13 * 33], 0, false); w = __builtin_amdgcn_cvt_pk_fp8_f32(q[14 * 33], q[15 * 33], w, true); o.w = (unsigned)w;
        *(u32x4*)(dst_n0 + (size_t)n * ldd + k0 + 16 * c) = o;
    }
    asm volatile("s_waitcnt lgkmcnt(0)" ::: "memory");
}

struct TrPair { f32x4 v[2][8]; };
__device__ __forceinline__ void tr_pair_load(TrPair& t, const float* src, int ld, int k0, int n0, int lane) {
#pragma unroll
    for (int h = 0; h < 2; ++h)
#pragma unroll
        for (int i = 0; i < 8; ++i) { const float* q = src + (size_t)(k0 + 64 * h + 8 * i + (lane >> 3)) * ld + n0 + 4 * (lane & 7);
            asm volatile("global_load_dwordx4 %0, %1, off nt" : "=&v"(t.v[h][i]) : "v"(q) : "memory"); }
}
#define TR_PAIR_WAIT(t, n) asm volatile("s_waitcnt vmcnt(" #n ")" : "+v"(t.v[0][0]), "+v"(t.v[0][1]), "+v"(t.v[0][2]), "+v"(t.v[0][3]), "+v"(t.v[0][4]), "+v"(t.v[0][5]), "+v"(t.v[0][6]), "+v"(t.v[0][7]), \
        "+v"(t.v[1][0]), "+v"(t.v[1][1]), "+v"(t.v[1][2]), "+v"(t.v[1][3]), "+v"(t.v[1][4]), "+v"(t.v[1][5]), "+v"(t.v[1][6]), "+v"(t.v[1][7]) :: "memory")
__device__ __forceinline__ void tr_pair_store(const TrPair& t, int k0, unsigned char* dst_n0, int ldd, float sc, LAS float* scr, int lane) {
#pragma unroll
    for (int h = 0; h < 2; ++h) {
#pragma unroll
        for (int i = 0; i < 8; ++i) { const int kk = 8 * i + (lane >> 3); LAS float* q = scr + kk * 33 + 4 * (lane & 7);
            q[0] = t.v[h][i].x * sc; q[1] = t.v[h][i].y * sc; q[2] = t.v[h][i].z * sc; q[3] = t.v[h][i].w * sc; }
        asm volatile("s_waitcnt lgkmcnt(0)" ::: "memory");
        const int c = lane & 3;
#pragma unroll
        for (int j = 0; j < 2; ++j) {
            const int n = (lane >> 2) + 16 * j; const LAS float* q = scr + (16 * c) * 33 + n;
            u32x4 o; int w;
            w = __builtin_amdgcn_cvt_pk_fp8_f32(q[0 * 33], q[1 * 33], 0, false); w = __builtin_amdgcn_cvt_pk_fp8_f32(q[2 * 33], q[3 * 33], w, true); o.x = (unsigned)w;
            w = __builtin_amdgcn_cvt_pk_fp8_f32(q[4 * 33], q[5 * 33], 0, false); w = __builtin_amdgcn_cvt_pk_fp8_f32(q[6 * 33], q[7 * 33], w, true); o.y = (unsigned)w;
            w = __builtin_amdgcn_cvt_pk_fp8_f32(q[8 * 33], q[9 * 33], 0, false); w = __builtin_amdgcn_cvt_pk_fp8_f32(q[10 * 33], q[11 * 33], w, true); o.z = (unsigned)w;
            w = __builtin_amdgcn_cvt_pk_fp8_f32(q[12 * 33], q[13 * 33], 0, false); w = __builtin_amdgcn_cvt_pk_fp8_f32(q[14 * 33], q[15 * 33], w, true); o.w = (unsigned)w;
            *(u32x4*)(dst_n0 + (size_t)n * ldd + k0 + 64 * h + 16 * c) = o;
        }
        asm volatile("s_waitcnt lgkmcnt(0)" ::: "memory");
    }
}

struct ExpItem { const float* src; unsigned char* dst; int ld, ldd, k0, n0; };
__device__ __forceinline__ ExpItem exp_item(const P& p, int r) {
    constexpr int I_2 = 32 * 512;
    ExpItem it;
    if (r < I_2) { const int e = r / 512, q = r % 512, kb = q / 64, nb = q % 64;
        it.src = p.w2 + (size_t)e * DE * DM; it.ld = DM; it.k0 = 128 * kb; it.n0 = 32 * nb; it.dst = (unsigned char*)(p.ws + WS_W2) + ((size_t)e * DM + 32 * nb) * DE; it.ldd = DE; }
    else { r -= I_2; const int mat = r / 512, q = r % 512, e = mat >> 1, which = mat & 1, kb = q / 32, nb = q % 32; const int n0 = 32 * nb;
        it.src = (which ? p.w3 : p.w1) + (size_t)e * DM * DE; it.ld = DE; it.k0 = 128 * kb; it.n0 = n0;
        it.dst = (unsigned char*)(p.ws + WS_W13) + ((size_t)(e * 8 + n0 / 128) * 256 + (n0 % 128) + which * 128) * DM; it.ldd = DM; }
    return it;
}
constexpr int EXP_NIT = 96 * 512, EXP_CHUNK = 64, EXP_NCHUNK = EXP_NIT / EXP_CHUNK;
constexpr int AT_NA = 32;
__device__ __forceinline__ void exp_convert_range(const P& p, LAS unsigned char* lds, int r0, int r_end, int stride) {
    const int tid = otid(), lane = tid & 63, wave = tid >> 6;
    LAS float* scr = (LAS float*)(lds + wave * 8704);
    TrPair A, B; ExpItem ia, ib;
    int r = r0;
    if (r < r_end) { ia = exp_item(p, r); tr_pair_load(A, ia.src, ia.ld, ia.k0, ia.n0, lane); }
    while (r < r_end) {
        const int r1 = r + stride; const bool m1 = r1 < r_end;
        if (m1) { ib = exp_item(p, r1); tr_pair_load(B, ib.src, ib.ld, ib.k0, ib.n0, lane); TR_PAIR_WAIT(A, 16); } else TR_PAIR_WAIT(A, 0);
        tr_pair_store(A, ia.k0, ia.dst, ia.ldd, 64.f, scr, lane);
        if (!m1) break;
        const int r2 = r1 + stride; const bool m2 = r2 < r_end;
        if (m2) { ia = exp_item(p, r2); tr_pair_load(A, ia.src, ia.ld, ia.k0, ia.n0, lane); TR_PAIR_WAIT(B, 16); } else TR_PAIR_WAIT(B, 0);
        tr_pair_store(B, ib.k0, ib.dst, ib.ldd, 64.f, scr, lane);
        r = r2;
    }
}
__device__ __forceinline__ void ph_convert_chunk(const P& p, LAS unsigned char* lds, int c) {
    __syncthreads();
    exp_convert_range(p, lds, c * EXP_CHUNK + (otid() >> 6), (c + 1) * EXP_CHUNK, 8);
    __syncthreads();
}
__device__ __forceinline__ void ph_prep_experts(const P& p, LAS unsigned char* lds) {
    exp_convert_range(p, lds, 512 * EXP_CHUNK + (int)blockIdx.x * 8 + (otid() >> 6), EXP_NIT, (int)gridDim.x * 8);
}

__device__ __forceinline__ void ph_prep(const P& p, LAS unsigned char* lds) {
    const int tid = otid(), lane = tid & 63, wave = tid >> 6;
    const int gw = blockIdx.x * 8 + wave, NGW = gridDim.x * 8;
    unsigned char* ws = p.ws;
    LAS float* scr = (LAS float*)(lds + wave * 8704);
    constexpr int I_IN = 32 * 128, I_OUT = 32 * 64, I_13 = 0, I_2 = 0, I_UKV = 16;
    constexpr int NIT = I_IN + I_OUT + I_13 + I_2 + I_UKV;
    for (int it = gw; it < NIT; it += NGW) {
        int r = it;
        if (r < I_IN) { const int kb = r / 128, nb = r % 128;
            if (nb < 96) tr_item_fp8(p.w_in, INC, 64 * kb, 32 * nb, (unsigned char*)(ws + WS_WIN8) + (size_t)(32 * nb) * DM, DM, 64.f, scr, lane);
            else tr_item(p.w_in, INC, INC, 64 * kb, 32 * nb, (bf16*)(ws + WS_WIN) + (size_t)(32 * nb) * DM, DM, nullptr, scr, lane);
            continue; }
        r -= I_IN;
        if (r < I_OUT) { const int kb = r / 64, nb = r % 64; const int k0 = 64 * kb;
            tr_item_fp8(p.w_out, DM, k0, 32 * nb, (unsigned char*)(ws + WS_WOUT) + (size_t)(32 * nb) * DM, DM, 64.f, scr, lane, (k0 < 1024) ? p.gnorm_a_g : (p.gnorm_b_g - 1024)); continue; }
        r -= I_OUT;
        if (r < I_13) { const int mat = r / 1024, q = r % 1024, e = mat >> 1, which = mat & 1, kb = q / 32, nb = q % 32; const int n0 = 32 * nb;
            const float* src = (which ? p.w3 : p.w1) + (size_t)e * DM * DE;
            unsigned char* dst = (unsigned char*)(ws + WS_W13) + ((size_t)(e * 8 + n0 / 128) * 256 + (n0 % 128) + which * 128) * DM;
            tr_item_fp8(src, DE, 64 * kb, n0, dst, DM, 64.f, scr, lane);
            continue; }
        r -= I_13;
        if (r < I_2) { const int e = r / 1024, q = r % 1024, kb = q / 64, nb = q % 64;
            tr_item_fp8(p.w2 + (size_t)e * DE * DM, DM, 64 * kb, 32 * nb, (unsigned char*)(ws + WS_W2) + ((size_t)e * DM + 32 * nb) * DE, DE, 64.f, scr, lane); continue; }
        r -= I_2;
        { const int which = r / 8, q = r % 8, kb = q / 2, nb = q % 2;
          tr_item(which ? p.w_uv : p.w_uk, 64, 64, 64 * kb, 32 * nb, (bf16*)(ws + WS_WUKV) + (size_t)(which * 64 + 32 * nb) * 256, 256, p.kv_norm_g, scr, lane); }
    }
    const int gt = blockIdx.x * 512 + tid, NGT = gridDim.x * 512;
    for (int i = gt; i < 8 * 128 * 128; i += NGT) { const int ii = (i >> 7) & 127, j = i & 127; ((bf16*)(ws + WS_WSP))[i] = ((ii >> 6) >= (j >> 6)) ? (bf16)f2bf(p.w_sp[i]) : (bf16)0; }
    for (int i = gt; i < 48 * 2048; i += NGT) { const int n = i / 2048, k = i % 2048; float v = 0.f; if (n < 4) v = p.w_group[k * 4 + n]; else if (n < 36) v = p.w_expert[k * 32 + (n - 4)]; ((bf16*)(ws + WS_WR))[i] = (bf16)f2bf(v); }
    for (int i = gt; i < NT * 32; i += NGT) { const int tok = i >> 5, f = i & 31; const float ang = (float)p.pos[tok] * p.freqs[f]; float s, c; sincos_acc(ang, s, c); ((f32x2*)(ws + WS_CS))[i] = (f32x2){c, s}; }
}
__device__ __forceinline__ void ph_prep_ada(const P& p, LAS unsigned char* lds) {
    const int tid = otid();
    unsigned char* ws = p.ws;
    __syncthreads();
    LAS float* sl = (LAS float*)lds;
    LAS float* red = (LAS float*)(lds + 65536);
    for (int i = tid; i < 8 * 2048; i += 512) sl[i] = silu_f(p.c[i]);
    __syncthreads();
    for (int cb = blockIdx.x; cb < 256; cb += gridDim.x) {
        const int cg = tid % 12, kl = tid / 12, col0 = cb * 48 + 4 * cg;
        if (kl < 42) {
            f32x4 acc[8];
#pragma unroll
            for (int b = 0; b < 8; ++b) acc[b] = (f32x4){0.f, 0.f, 0.f, 0.f};
            for (int j0 = 0; j0 < 49; j0 += 7) {
                f32x4 w[7];
#pragma unroll
                for (int j = 0; j < 7; ++j) { const int k = kl + 42 * (j0 + j); w[j] = (k < 2048) ? __builtin_nontemporal_load((const f32x4*)(p.w_ada + (size_t)k * 12288 + col0)) : (f32x4){0.f, 0.f, 0.f, 0.f}; }
#pragma unroll
                for (int j = 0; j < 7; ++j) { const int k = kl + 42 * (j0 + j); const int kc = k < 2048 ? k : 2047;
#pragma unroll
                    for (int b = 0; b < 8; ++b) acc[b] += w[j] * sl[b * 2048 + kc]; }
            }
#pragma unroll
            for (int b = 0; b < 8; ++b)
#pragma unroll
                for (int e = 0; e < 4; ++e) red[(kl * 8 + b) * 48 + 4 * cg + e] = acc[b][e];
        }
        __syncthreads();
        if (tid < 384) { const int b = tid / 48, cc = tid % 48; float s = 0.f; for (int k = 0; k < 42; ++k) s += red[(k * 8 + b) * 48 + cc];
            ((float*)(ws + WS_MOD))[b * 12288 + cb * 48 + cc] = s + p.b_ada[cb * 48 + cc]; }
        __syncthreads();
    }
}

__device__ __forceinline__ void ph_h(const P& p) {
    const int tid = otid(), lane = tid & 63, wave = tid >> 6;
    const int gw = blockIdx.x * 8 + wave, NGW = gridDim.x * 8;
    const float* mod = (const float*)(p.ws + WS_MOD);
    bf16* H = (bf16*)(p.ws + WS_H);
    for (int m0 = 2 * gw; m0 < NT; m0 += 2 * NGW) {
        f32x4 v[2][8]; float ss[2] = {0.f, 0.f};
#pragma unroll
        for (int r = 0; r < 2; ++r) { const f32x4* xr = (const f32x4*)(p.x + (size_t)(m0 + r) * DM) + lane;
#pragma unroll
            for (int j = 0; j < 8; ++j) v[r][j] = __builtin_nontemporal_load(xr + 64 * j); }
#pragma unroll
        for (int r = 0; r < 2; ++r) {
            const int m = m0 + r, b = m >> 12;
#pragma unroll
            for (int j = 0; j < 8; ++j) ss[r] += v[r][j].x * v[r][j].x + v[r][j].y * v[r][j].y + v[r][j].z * v[r][j].z + v[r][j].w * v[r][j].w;
            const float rstd = __builtin_amdgcn_rsqf(wave_sum(ss[r]) * (1.f / DM) + EPS);
            u32x2* o = (u32x2*)(H + (size_t)m * DM) + lane;
#pragma unroll
            for (int j = 0; j < 8; ++j) {
                const int col = 4 * lane + 256 * j;
                const f32x4 g = *(const f32x4*)(p.norm1_g + col), sh = *(const f32x4*)(mod + b * 12288 + col), sc = *(const f32x4*)(mod + b * 12288 + 2048 + col);
                const f32x4 h = v[r][j] * rstd * g * (sc + 1.f) + sh;
                o[64 * j] = (u32x2){pk2(h.x, h.y), pk2(h.z, h.w)};
                { int q8 = __builtin_amdgcn_cvt_pk_fp8_f32(h.x, h.y, 0, false); q8 = __builtin_amdgcn_cvt_pk_fp8_f32(h.z, h.w, q8, true); ((unsigned*)(p.ws + WS_H8 + (size_t)m * DM))[lane + 64 * j] = (unsigned)q8; }
            }
        }
    }
}


namespace pg8 {
constexpr int BM = 256, BK = 64, HALF = 128, HTB = HALF * BK * 2, STAGE_BYTES = 8 * HTB, NXCD = 8, WGM = 8;
__device__ __forceinline__ int lds_byte(int r, int c) { const int st = (r >> 4) * 2 + (c >> 5), rr = r & 15, cc = c & 31, ob = rr * 64 + cc * 2; return st * 1024 + (ob ^ (((ob >> 9) & 1) << 5)); }
__device__ __forceinline__ void stage_rc(int b, int& R, int& C) { const int st = b / 1024, sb = b % 1024, swz = sb ^ (((sb >> 9) & 1) << 5); R = (st >> 1) * 16 + swz / 64; C = (st & 1) * 32 + (swz % 64) / 2; }
__device__ __forceinline__ int perm32(int rho) { const int n = rho >> 4, i = rho & 15; return 8 * (i >> 2) + 4 * n + (i & 3); }
struct Unit { int pm, pn, e, p0, nv; };

typedef int v8i __attribute__((ext_vector_type(8)));
typedef int v4i __attribute__((ext_vector_type(4)));
__device__ __forceinline__ v8i cat8(bf16x8 lo, bf16x8 hi) { const v4i a = __builtin_bit_cast(v4i, lo), b = __builtin_bit_cast(v4i, hi); return __builtin_shufflevector(a, b, 0, 1, 2, 3, 4, 5, 6, 7); }
struct StaticOrder {
    int nM, nN, nwg, G, c;
    __device__ void init(int M, int N, int G_, int c_) { nM = M / BM; nN = N / BM; nwg = nM * nN; G = G_; c = c_; }
    __device__ bool next(int i, Unit& u) const {
        const long L = (long)i * G + c; if (L >= nwg) return false;
        int wgid = (int)L; { const int q = nwg / NXCD, r = nwg % NXCD, xcd = wgid % NXCD, off = wgid / NXCD; wgid = (xcd < r ? xcd * (q + 1) : r * (q + 1) + (xcd - r) * q) + off; }
        const int nig = WGM * nN, gid = wgid / nig, fm = gid * WGM, gsz = (nM - fm) < WGM ? (nM - fm) : WGM;
        u.pm = fm + ((wgid % nig) % gsz); u.pn = (wgid % nig) / gsz; u.e = 0; u.p0 = 0; u.nv = 256; return true;
    }
};

template <bool FP8> struct FragSel;
template <> struct FragSel<false> { struct A4 { bf16x8 f[4][2]; }; struct B2 { bf16x8 f[2][2]; }; };
template <> struct FragSel<true>  { struct A4 { v8i f[4]; };       struct B2 { v8i f[2]; }; };
template <bool FP8, class Epi, class Sched, class Ops>
__device__ __forceinline__ void gemm_phase(LAS unsigned char* lds, const Ops& O, const Sched& S, const Epi& E) {
    const int tid = otid(), wid = __builtin_amdgcn_readfirstlane(tid >> 6), lane = tid & 63, wr = wid >> 2, wc = wid & 3, fr = lane & 15, fq = lane >> 4;
    const int K = O.K, nt = K / BK;
    unsigned voffB[2], voffA[2];
    { int R0, C0, R1, C1; stage_rc(tid * 16, R0, C0); stage_rc(tid * 16 + 8192, R1, C1);
      const int Rb0 = Epi::PERM ? ((R0 & ~31) + perm32(R0 & 31)) : R0, Rb1 = Epi::PERM ? ((R1 & ~31) + perm32(R1 & 31)) : R1;
      voffB[0] = (unsigned)(Rb0 * K + C0) * 2u; voffB[1] = (unsigned)(Rb1 * K + C1) * 2u;
      voffA[0] = (unsigned)(R0 * K + C0) * 2u; voffA[1] = (unsigned)(R1 * K + C1) * 2u; }
    const size_t kstep = (size_t)(BK * 2);
    const size_t hstep = (size_t)HALF * K * 2;
    const unsigned ldsw = (unsigned)wid * 1024u;
    const int aoff = lds_byte(wr * 64 + fr, fq * 8), boff = lds_byte(wc * 32 + fr, fq * 8);
    const char* const Ab = (const char*)O.A;
#define PG8_SA(b, h) (((b) * 2 + (h)) * HTB)
#define PG8_SB(b, h) ((4 + (b) * 2 + (h)) * HTB)
#define PG8_STAGEB(bufoff, gbase) do { _Pragma("unroll") for (int _i = 0; _i < 2; ++_i) \
        __builtin_amdgcn_global_load_lds((const unsigned*)((const char*)(gbase) + voffB[_i]), (LAS unsigned*)(lds + (bufoff) + ldsw + _i * 8192), 16, 0, 0); } while (0)
#define PG8_STAGEA(bufoff, ub, h, kb) do { _Pragma("unroll") for (int _i = 0; _i < 2; ++_i) { \
        if constexpr (Ops::GATHER) { unsigned _v = ((h) ? vc1 : vc0)[_i]; asm volatile("" : "+v"(_v)); \
            __builtin_amdgcn_global_load_lds((const unsigned*)(Ab + (kb) + _v), (LAS unsigned*)(lds + (bufoff) + ldsw + _i * 8192), 16, 0, 0); } \
        else __builtin_amdgcn_global_load_lds((const unsigned*)(Ab + (ub) + (size_t)(h) * hstep + (kb) + voffA[_i]), (LAS unsigned*)(lds + (bufoff) + ldsw + _i * 8192), 16, 0, 0); } } while (0)
#define PG8_LDA(dst, b, h) do { _Pragma("unroll") for (int m = 0; m < 4; ++m) { const bf16x8 _l = *(const LAS bf16x8*)(lds + PG8_SA(b, h) + aoff + m * 2048), _h = *(const LAS bf16x8*)(lds + PG8_SA(b, h) + aoff + m * 2048 + 1024); \
        if constexpr (FP8) dst.f[m] = cat8(_l, _h); else { dst.f[m][0] = _l; dst.f[m][1] = _h; } } } while (0)
#define PG8_LDB(dst, b, h) do { _Pragma("unroll") for (int n = 0; n < 2; ++n) { const bf16x8 _l = *(const LAS bf16x8*)(lds + PG8_SB(b, h) + boff + n * 2048), _h = *(const LAS bf16x8*)(lds + PG8_SB(b, h) + boff + n * 2048 + 1024); \
        if constexpr (FP8) dst.f[n] = cat8(_l, _h); else { dst.f[n][0] = _l; dst.f[n][1] = _h; } } } while (0)
#define PG8_MMA(ai, bj, At, Bt) do { __builtin_amdgcn_s_setprio(1); _Pragma("unroll") for (int m = 0; m < 4; ++m) _Pragma("unroll") for (int n = 0; n < 2; ++n) { \
        if constexpr (FP8) { asm("v_mfma_scale_f32_16x16x128_f8f6f4 %0, %1, %2, %0, %3, %4 op_sel_hi:[0,0,0]" : "+v"(acc[ai][bj][m][n]) : "v"(Bt.f[n]), "v"(At.f[m]), "v"(sc_w), "v"(sc_a)); } \
        else { _Pragma("unroll") for (int k = 0; k < 2; ++k) acc[ai][bj][m][n] = __builtin_amdgcn_mfma_f32_16x16x32_bf16(Bt.f[n][k], At.f[m][k], acc[ai][bj][m][n], 0, 0, 0); } } \
        __builtin_amdgcn_s_setprio(0); } while (0)
#define PG8_WAIT_V(n) asm volatile("s_waitcnt vmcnt(" #n ")" ::: "memory")
#define PG8_WAIT_L(n) asm volatile("s_waitcnt lgkmcnt(" #n ")" ::: "memory")
#define PG8_BAR __builtin_amdgcn_s_barrier()
#define PG8_SCHED __builtin_amdgcn_sched_barrier(0)
    Unit cur, nxt; int ui = 0;
    if (!S.next(0, cur)) return;
    f32x4 acc[2][2][4][2];
#pragma unroll
    for (int a = 0; a < 2; ++a)
#pragma unroll
        for (int b = 0; b < 2; ++b)
#pragma unroll
            for (int m = 0; m < 4; ++m)
#pragma unroll
                for (int n = 0; n < 2; ++n) acc[a][b][m][n] = (f32x4){0.f, 0.f, 0.f, 0.f};
    typedef typename FragSel<FP8>::A4 FA; typedef typename FragSel<FP8>::B2 FB;
    FA At; FB B0, B1;
    const int sc_w = O.scale_w, sc_a = O.scale_a; (void)sc_w; (void)sc_a;
    unsigned vc0[2] = {0u, 0u}, vc1[2] = {0u, 0u};
    if constexpr (Ops::GATHER) O.a_off(cur, tid, vc0, vc1);
    size_t cU = O.a_base(cur);
    const char* cB = O.b_base(cur);
    PG8_STAGEB(PG8_SB(0, 0), cB); PG8_STAGEB(PG8_SB(0, 1), cB + hstep); PG8_STAGEA(PG8_SA(0, 0), cU, 0, 0); PG8_STAGEA(PG8_SA(0, 1), cU, 1, 0);
    if (wr == 1) PG8_BAR;
    PG8_WAIT_V(2); PG8_BAR;
    PG8_STAGEB(PG8_SB(1, 0), cB + kstep); PG8_STAGEA(PG8_SA(1, 0), cU, 0, kstep); PG8_STAGEB(PG8_SB(1, 1), cB + hstep + kstep);
    PG8_WAIT_V(6); PG8_BAR;
    for (;;) {
        const bool has_next = S.next(ui + 1, nxt);
        const char* nB = has_next ? O.b_base(nxt) : cB;
        const size_t nU = has_next ? O.a_base(nxt) : cU;
        for (int t = 0; t < nt; t += 2) {
            const bool last = (t == nt - 2);
            const size_t k1 = (size_t)(t + 1) * kstep;
            const size_t k2 = last ? 0 : (size_t)(t + 2) * kstep, k3 = k2 + kstep;
            const size_t u2 = last ? nU : cU;
            const char* b2 = last ? nB : cB + (size_t)(t + 2) * kstep; const char* b3 = b2 + kstep;
            unsigned vt1[2] = {vc1[0], vc1[1]};
            if constexpr (Ops::GATHER) { if (last && has_next) { unsigned n0[2], n1[2]; O.a_off(nxt, tid, n0, n1); vc0[0] = n0[0]; vc0[1] = n0[1]; vt1[0] = n1[0]; vt1[1] = n1[1]; } }
            PG8_LDB(B0, 0, 0); PG8_LDB(B1, 0, 1); PG8_SCHED; PG8_LDA(At, 0, 0); PG8_STAGEA(PG8_SA(1, 1), cU, 1, k1);
            if constexpr (Ops::GATHER) { vc1[0] = vt1[0]; vc1[1] = vt1[1]; }
            PG8_WAIT_V(8); PG8_WAIT_L(0); PG8_BAR; PG8_MMA(0, 0, At, B0); PG8_MMA(0, 1, At, B1); PG8_BAR; PG8_SCHED;
            PG8_LDA(At, 0, 1); PG8_STAGEB(PG8_SB(0, 0), b2); PG8_STAGEB(PG8_SB(0, 1), b2 + hstep); PG8_STAGEA(PG8_SA(0, 0), u2, 0, k2);
            PG8_WAIT_V(8); PG8_WAIT_L(0); PG8_BAR; PG8_MMA(1, 0, At, B0); PG8_MMA(1, 1, At, B1); PG8_BAR; PG8_SCHED;
            PG8_LDB(B0, 1, 0); PG8_LDB(B1, 1, 1); PG8_SCHED; PG8_LDA(At, 1, 0); PG8_STAGEA(PG8_SA(0, 1), u2, 1, k2);
            PG8_WAIT_V(8); PG8_WAIT_L(0); PG8_BAR; PG8_MMA(0, 0, At, B0); PG8_MMA(0, 1, At, B1); PG8_BAR; PG8_SCHED;
            PG8_LDA(At, 1, 1); PG8_STAGEB(PG8_SB(1, 0), b3); PG8_STAGEB(PG8_SB(1, 1), b3 + hstep); PG8_STAGEA(PG8_SA(1, 0), u2, 0, k3);
            PG8_WAIT_V(8); PG8_WAIT_L(0); PG8_BAR; PG8_MMA(1, 0, At, B0); PG8_MMA(1, 1, At, B1); PG8_BAR; PG8_SCHED;
        }
        if (wr == 0) PG8_BAR;
        if constexpr (FP8) asm volatile("s_nop 15\n\ts_nop 15" ::: "memory");
        E(acc, cur, wr, wc, fr, fq);
        if (!has_next) break;
#pragma unroll
        for (int a = 0; a < 2; ++a)
#pragma unroll
            for (int b = 0; b < 2; ++b)
#pragma unroll
                for (int m = 0; m < 4; ++m)
#pragma unroll
                    for (int n = 0; n < 2; ++n) acc[a][b][m][n] = (f32x4){0.f, 0.f, 0.f, 0.f};
        cur = nxt; cB = nB; cU = nU; ++ui;
        if (wr == 1) PG8_BAR;
    }
    PG8_WAIT_V(0);
    PG8_BAR;
#undef PG8_SA
#undef PG8_SB
#undef PG8_STAGEA
#undef PG8_STAGEB
#undef PG8_LDA
#undef PG8_LDB
#undef PG8_MMA
#undef PG8_WAIT_V
#undef PG8_WAIT_L
#undef PG8_BAR
#undef PG8_SCHED
}
}

struct OpsDense {
    static constexpr bool GATHER = false;
    const bf16* A; const bf16* Bt; int K; static constexpr int scale_w = 0x7f, scale_a = 0x7f;
    __device__ __forceinline__ const char* b_base(const pg8::Unit& u) const { return (const char*)Bt + (size_t)u.pn * 256 * K * 2; }
    __device__ __forceinline__ size_t a_base(const pg8::Unit& u) const { return (size_t)u.pm * 256 * K * 2; }
    __device__ __forceinline__ void a_off(const pg8::Unit&, int, unsigned (&)[2], unsigned (&)[2]) const {}
};
struct EpiInproj {
    static constexpr bool PERM = true;
    bf16* Oq; int coff; int nact;
    __device__ __forceinline__ void operator()(const f32x4 (&acc)[2][2][4][2], const pg8::Unit& u, int wr, int wc, int fr, int fq) const {
        const int row0 = u.pm * 256 + wr * 64 + fr, col0 = coff + u.pn * 256 + wc * 32 + 8 * fq;
        const bool act = u.pn < nact;
#pragma unroll
        for (int ai = 0; ai < 2; ++ai)
#pragma unroll
            for (int m = 0; m < 4; ++m) { bf16* rowp = Oq + (size_t)(row0 + ai * 128 + m * 16) * NPROJ + col0;
#pragma unroll
                for (int bj = 0; bj < 2; ++bj) { f32x4 v0 = acc[ai][bj][m][0], v1 = acc[ai][bj][m][1];
                    if (act) { v0.x = gelu_tanh(v0.x); v0.y = gelu_tanh(v0.y); v0.z = gelu_tanh(v0.z); v0.w = gelu_tanh(v0.w); v1.x = gelu_tanh(v1.x); v1.y = gelu_tanh(v1.y); v1.z = gelu_tanh(v1.z); v1.w = gelu_tanh(v1.w); }
                    u32x4 w; w.x = pk2(v0.x, v0.y); w.y = pk2(v0.z, v0.w); w.z = pk2(v1.x, v1.y); w.w = pk2(v1.z, v1.w);
                    __builtin_nontemporal_store(w, (u32x4*)(rowp + bj * 128)); } }
    }
};
struct EpiOutproj {
    static constexpr bool PERM = true;
    const float* x; const float* mod; bf16* x1; const float* rsa;
    __device__ __forceinline__ void operator()(const f32x4 (&acc)[2][2][4][2], const pg8::Unit& u, int wr, int wc, int fr, int fq) const {
        const int row0 = u.pm * 256 + wr * 64 + fr, col0 = u.pn * 256 + wc * 32 + 8 * fq;
        const int b = (u.pm * 256) >> 12;
        f32x4 g[2][2];
#pragma unroll
        for (int bj = 0; bj < 2; ++bj)
#pragma unroll
            for (int n = 0; n < 2; ++n) g[bj][n] = *(const f32x4*)(mod + b * 12288 + 2 * 2048 + col0 + bj * 128 + 4 * n);
#pragma unroll
        for (int ai = 0; ai < 2; ++ai)
#pragma unroll
            for (int m = 0; m < 4; ++m) { const size_t ro = (size_t)(row0 + ai * 128 + m * 16) * DM + col0; const float rsc = rsa[row0 + ai * 128 + m * 16];
#pragma unroll
                for (int bj = 0; bj < 2; ++bj) { const f32x4 x0 = *(const f32x4*)(x + ro + bj * 128), x1v = *(const f32x4*)(x + ro + bj * 128 + 4);
                    const f32x4 v0 = x0 + g[bj][0] * (acc[ai][bj][m][0] * rsc), v1 = x1v + g[bj][1] * (acc[ai][bj][m][1] * rsc);
                    *(u32x4*)(x1 + ro + bj * 128) = (u32x4){pk2(v0.x, v0.y), pk2(v0.z, v0.w), pk2(v1.x, v1.y), pk2(v1.z, v1.w)}; } }
    }
};
constexpr int LDS_MOE_EBASE = 131072, LDS_MOE_TILE = 131072 + 256;
__device__ __forceinline__ int moe_tables(const P& p, LAS unsigned char* lds) {
    const unsigned* cnt = (const unsigned*)(p.ws + WS_CTL) + CW_CNT;
    LAS int* ebase = (LAS int*)(lds + LDS_MOE_EBASE); LAS int* tile_e = (LAS int*)(lds + LDS_MOE_TILE);
    __syncthreads();
    if (threadIdx.x == 0) { int run = 0; for (int e = 0; e < NE; ++e) { ebase[e] = run; run += ((int)cnt[e] + 255) & ~255; } ebase[NE] = run; }
    __syncthreads();
    const int ntl = ebase[NE] >> 8;
    for (int t = threadIdx.x; t < ntl; t += 512) { int e = 0; while (e < NE - 1 && ebase[e + 1] <= 256 * t) ++e; tile_e[t] = e; }
    __syncthreads();
    return ntl;
}
struct MoeSched {
    int ntl, c; const LAS int* tile_e; const LAS int* ebase; const unsigned* cnt;
    __device__ __forceinline__ bool next(int i, pg8::Unit& u) const {
        const int x = c & 7, j = c >> 3;
        const int st = 32 * i + 4 * x + (j >> 3);
        if (st >= ntl) return false;
        const int e = tile_e[st];
        u.pm = st; u.pn = j & 7; u.e = e; u.p0 = 256 * st - ebase[e]; u.nv = (int)cnt[e] - u.p0; return true;
    }
};
struct OpsMoe1 {
    static constexpr bool GATHER = true;
    const bf16* A; const bf16* Bt; int K; const int* list; static constexpr int scale_w = 0x7c, scale_a = 0x7c;
    __device__ __forceinline__ const char* b_base(const pg8::Unit& u) const { return (const char*)Bt + (size_t)(u.e * 8 + u.pn) * 256 * DM; }
    __device__ __forceinline__ size_t a_base(const pg8::Unit&) const { return 0; }
    __device__ __forceinline__ void a_off(const pg8::Unit& u, int tid, unsigned (&v0)[2], unsigned (&v1)[2]) const {
        int R0, C0, R1, C1; pg8::stage_rc(tid * 16, R0, C0); pg8::stage_rc(tid * 16 + 8192, R1, C1);
        const int* le = list + (size_t)u.e * NT + u.p0; const int lim = u.nv - 1;
        const int r00 = R0 < lim ? R0 : lim, r01 = R1 < lim ? R1 : lim, r10 = (128 + R0) < lim ? (128 + R0) : lim, r11 = (128 + R1) < lim ? (128 + R1) : lim;
        v0[0] = (unsigned)le[r00] * (unsigned)DM + C0 * 2u; v0[1] = (unsigned)le[r01] * (unsigned)DM + C1 * 2u;
        v1[0] = (unsigned)le[r10] * (unsigned)DM + C0 * 2u; v1[1] = (unsigned)le[r11] * (unsigned)DM + C1 * 2u;
    }
};
struct OpsMoe2 {
    static constexpr bool GATHER = false;
    const bf16* A; const bf16* Bt; int K; static constexpr int scale_w = 0x7b, scale_a = 0x7b;
    __device__ __forceinline__ const char* b_base(const pg8::Unit& u) const { return (const char*)Bt + ((size_t)u.e * DM + (size_t)u.pn * 256) * DE; }
    __device__ __forceinline__ size_t a_base(const pg8::Unit& u) const { return (size_t)u.pm * 256 * DE; }
    __device__ __forceinline__ void a_off(const pg8::Unit&, int, unsigned (&)[2], unsigned (&)[2]) const {}
};
struct EpiMoe1 {
    static constexpr bool PERM = true;
    bf16* act;
    __device__ __forceinline__ void operator()(const f32x4 (&acc)[2][2][4][2], const pg8::Unit& u, int wr, int wc, int fr, int fq) const {
        const int row0 = u.pm * 256 + wr * 64 + fr, col0 = u.pn * 128 + wc * 32 + 8 * fq;
#pragma unroll
        for (int ai = 0; ai < 2; ++ai)
#pragma unroll
            for (int m = 0; m < 4; ++m) {
                const f32x4 a0 = acc[ai][0][m][0], a1 = acc[ai][0][m][1], g0 = acc[ai][1][m][0], g1 = acc[ai][1][m][1];
                int w0 = __builtin_amdgcn_cvt_pk_fp8_f32(4.f * silu_f(a0.x) * g0.x, 4.f * silu_f(a0.y) * g0.y, 0, false); w0 = __builtin_amdgcn_cvt_pk_fp8_f32(4.f * silu_f(a0.z) * g0.z, 4.f * silu_f(a0.w) * g0.w, w0, true);
                int w1 = __builtin_amdgcn_cvt_pk_fp8_f32(4.f * silu_f(a1.x) * g1.x, 4.f * silu_f(a1.y) * g1.y, 0, false); w1 = __builtin_amdgcn_cvt_pk_fp8_f32(4.f * silu_f(a1.z) * g1.z, 4.f * silu_f(a1.w) * g1.w, w1, true);
                *(u32x2*)((unsigned char*)act + (size_t)(row0 + ai * 128 + m * 16) * DE + col0) = (u32x2){(unsigned)w0, (unsigned)w1}; }
    }
};
struct EpiMoe2 {
    static constexpr bool PERM = true;
    bf16* ym;
    __device__ __forceinline__ void operator()(const f32x4 (&acc)[2][2][4][2], const pg8::Unit& u, int wr, int wc, int fr, int fq) const {
        const int row0 = u.pm * 256 + wr * 64 + fr, col0 = u.pn * 256 + wc * 32 + 8 * fq;
#pragma unroll
        for (int ai = 0; ai < 2; ++ai)
#pragma unroll
            for (int m = 0; m < 4; ++m) { unsigned char* rowp = (unsigned char*)ym + (size_t)(row0 + ai * 128 + m * 16) * DM + col0;
#pragma unroll
                for (int bj = 0; bj < 2; ++bj) { const f32x4 v0 = acc[ai][bj][m][0] * 16.f, v1 = acc[ai][bj][m][1] * 16.f;
                    int w0 = __builtin_amdgcn_cvt_pk_fp8_f32(v0.x, v0.y, 0, false); w0 = __builtin_amdgcn_cvt_pk_fp8_f32(v0.z, v0.w, w0, true);
                    int w1 = __builtin_amdgcn_cvt_pk_fp8_f32(v1.x, v1.y, 0, false); w1 = __builtin_amdgcn_cvt_pk_fp8_f32(v1.z, v1.w, w1, true);
                    *(u32x2*)(rowp + bj * 128) = (u32x2){(unsigned)w0, (unsigned)w1}; } }
    }
};
struct OpsDense8 {
    static constexpr bool GATHER = false;
    const bf16* A; const bf16* Bt; int K; static constexpr int scale_w = 0x7c, scale_a = 0x7c;
    __device__ __forceinline__ const char* b_base(const pg8::Unit& u) const { return (const char*)Bt + (size_t)u.pn * 256 * K * 2; }
    __device__ __forceinline__ size_t a_base(const pg8::Unit& u) const { return (size_t)u.pm * 256 * K * 2; }
    __device__ __forceinline__ void a_off(const pg8::Unit&, int, unsigned (&)[2], unsigned (&)[2]) const {}
};
__device__ __forceinline__ void ph_inproj_fp8(const P& p, LAS unsigned char* lds) {
    OpsDense8 O{(const bf16*)(p.ws + WS_H8), (const bf16*)(p.ws + WS_WIN8), DM / 2};
    pg8::StaticOrder S; S.init(NT, 3072, gridDim.x, blockIdx.x);
    EpiInproj E{(bf16*)(p.ws + WS_PROJ), 0, 8};
    pg8::gemm_phase<true>(lds, O, S, E);
}
__device__ __forceinline__ void ph_inproj_bf16(const P& p, LAS unsigned char* lds) {
    OpsDense O{(const bf16*)(p.ws + WS_H), (const bf16*)(p.ws + WS_WIN) + (size_t)3072 * DM, DM};
    pg8::StaticOrder S; S.init(NT, 1024, gridDim.x, blockIdx.x);
    EpiInproj E{(bf16*)(p.ws + WS_PROJ), 3072, 0};
    pg8::gemm_phase<false>(lds, O, S, E);
}
__device__ __forceinline__ void ph_inproj(const P& p, LAS unsigned char* lds) {
    if (blockIdx.x & 1) { ph_inproj_bf16(p, lds); ph_inproj_fp8(p, lds); } else { ph_inproj_fp8(p, lds); ph_inproj_bf16(p, lds); }
}
__device__ __forceinline__ void ph_outproj(const P& p, LAS unsigned char* lds) {
    OpsDense8 O{(const bf16*)(p.ws + WS_Y8), (const bf16*)(p.ws + WS_WOUT), DM / 2};
    pg8::StaticOrder S; S.init(NT, DM, gridDim.x, blockIdx.x);
    EpiOutproj E{p.x, (const float*)(p.ws + WS_MOD), (bf16*)(p.ws + WS_X1), (const float*)(p.ws + WS_SSQ)};
    pg8::gemm_phase<true>(lds, O, S, E);
}
__device__ __forceinline__ void ph_moe1(const P& p, LAS unsigned char* lds) {
    const int ntl = moe_tables(p, lds);
    int i_lo, i_hi;
    {
        constexpr int NW2 = 32 * 512, DU = 64;
        const int c = (int)blockIdx.x;
        int R = ntl - 256; R = R < 0 ? 0 : (R > 32 ? 32 : R);
        const int n9 = 8 * R, n8 = 256 - n9;
        int b_it = (NW2 - n8 * DU) / 256; b_it = b_it < 0 ? 0 : ((b_it + 7) & ~7);
        int a_it = n8 > 0 ? ((NW2 - n9 * b_it + n8 - 1) / n8 + 7) & ~7 : 0;
        if (n8 == 0) b_it = NW2 / 256;
        int r9 = 0;
        for (int k = 0; k < c; ++k) r9 += (4 * (k & 7) + (k >> 6) < R) ? 1 : 0;
        const bool h9 = 4 * (c & 7) + (c >> 6) < R;
        i_lo = r9 * b_it + (c - r9) * a_it; i_hi = i_lo + (h9 ? b_it : a_it);
        i_lo = i_lo < NW2 ? i_lo : NW2; i_hi = i_hi < NW2 ? i_hi : NW2; if (c == 255) i_hi = NW2;
    }
    const int wave = otid() >> 6;
    if (blockIdx.x & 1) { __syncthreads(); exp_convert_range(p, lds, i_lo + wave, i_hi, 8); __syncthreads(); }
    OpsMoe1 O{(const bf16*)(p.ws + WS_H), (const bf16*)(p.ws + WS_W13), DM / 2, (const int*)(p.ws + WS_LIST)};
    MoeSched S{ntl, (int)blockIdx.x, (const LAS int*)(lds + LDS_MOE_TILE), (const LAS int*)(lds + LDS_MOE_EBASE), (const unsigned*)(p.ws + WS_CTL) + CW_CNT};
    EpiMoe1 E{(bf16*)(p.ws + WS_ACT)};
    pg8::gemm_phase<true>(lds, O, S, E);
    if (!(blockIdx.x & 1)) { __syncthreads(); exp_convert_range(p, lds, i_lo + wave, i_hi, 8); __syncthreads(); }
}
__device__ __forceinline__ void ph_moe2(const P& p, LAS unsigned char* lds) {
    const int ntl = moe_tables(p, lds);
    OpsMoe2 O{(const bf16*)(p.ws + WS_ACT), (const bf16*)(p.ws + WS_W2), DE / 2};
    MoeSched S{ntl, (int)blockIdx.x, (const LAS int*)(lds + LDS_MOE_TILE), (const LAS int*)(lds + LDS_MOE_EBASE), (const unsigned*)(p.ws + WS_CTL) + CW_CNT};
    EpiMoe2 E{(bf16*)(p.ws + WS_YMOE)};
    pg8::gemm_phase<true>(lds, O, S, E);
}

__device__ __forceinline__ unsigned sortkey(float f) { const unsigned u = __float_as_uint(f); return (u & 0x80000000u) ? ~u : (u | 0x80000000u); }
__device__ __forceinline__ int cnt_ge8(const unsigned (&K)[64], int g, unsigned cand) {
    unsigned long long m0, m1, m2, m3, m4, m5, m6, m7;
    asm("v_cmp_ge_u32_e64 %0, %8, %16\n\tv_cmp_ge_u32_e64 %1, %9, %16\n\tv_cmp_ge_u32_e64 %2, %10, %16\n\tv_cmp_ge_u32_e64 %3, %11, %16\n\t"
        "v_cmp_ge_u32_e64 %4, %12, %16\n\tv_cmp_ge_u32_e64 %5, %13, %16\n\tv_cmp_ge_u32_e64 %6, %14, %16\n\tv_cmp_ge_u32_e64 %7, %15, %16"
        : "=&s"(m0), "=&s"(m1), "=&s"(m2), "=&s"(m3), "=&s"(m4), "=&s"(m5), "=&s"(m6), "=&s"(m7)
        : "v"(K[8 * g]), "v"(K[8 * g + 1]), "v"(K[8 * g + 2]), "v"(K[8 * g + 3]), "v"(K[8 * g + 4]), "v"(K[8 * g + 5]), "v"(K[8 * g + 6]), "v"(K[8 * g + 7]), "s"(cand));
    return (__popcll(m0) + __popcll(m1)) + (__popcll(m2) + __popcll(m3)) + ((__popcll(m4) + __popcll(m5)) + (__popcll(m6) + __popcll(m7)));
}
__device__ __forceinline__ int cnt_ge(unsigned k, unsigned cand) { unsigned long long m; asm("v_cmp_ge_u32_e64 %0, %1, %2" : "=s"(m) : "v"(k), "s"(cand)); return __popcll(m); }
__device__ __forceinline__ unsigned mbcnt64(unsigned long long m) { return __builtin_amdgcn_mbcnt_hi((unsigned)(m >> 32), __builtin_amdgcn_mbcnt_lo((unsigned)m, 0u)); }
__device__ __forceinline__ void ds_read_tr16x2(unsigned a0, unsigned a1, u32x2& r0, u32x2& r1) { asm volatile("ds_read_b64_tr_b16 %0, %2\n\tds_read_b64_tr_b16 %1, %3\n\ts_waitcnt lgkmcnt(0)" : "=&v"(r0), "=&v"(r1) : "v"(a0), "v"(a1) : "memory"); }
__device__ __forceinline__ void ds_read_tr16x8(unsigned a0, unsigned a1, u32x2 (&r)[4], u32x2 (&q)[4]) {
    asm volatile("ds_read_b64_tr_b16 %0, %8\n\tds_read_b64_tr_b16 %4, %9\n\tds_read_b64_tr_b16 %1, %8 offset:32\n\tds_read_b64_tr_b16 %5, %9 offset:32\n\t"
                 "ds_read_b64_tr_b16 %2, %8 offset:64\n\tds_read_b64_tr_b16 %6, %9 offset:64\n\tds_read_b64_tr_b16 %3, %8 offset:96\n\tds_read_b64_tr_b16 %7, %9 offset:96\n\ts_waitcnt lgkmcnt(0)"
                 : "=&v"(r[0]), "=&v"(r[1]), "=&v"(r[2]), "=&v"(r[3]), "=&v"(q[0]), "=&v"(q[1]), "=&v"(q[2]), "=&v"(q[3]) : "v"(a0), "v"(a1) : "memory");
}
__device__ __forceinline__ void rope8(const u32x4 lo, const u32x4 hi, const f32x2 (&cs)[8], u32x4& olo, u32x4& ohi) {
    float a[8] = {bflo(lo.x), bfhi(lo.x), bflo(lo.y), bfhi(lo.y), bflo(lo.z), bfhi(lo.z), bflo(lo.w), bfhi(lo.w)};
    float c[8] = {bflo(hi.x), bfhi(hi.x), bflo(hi.y), bfhi(hi.y), bflo(hi.z), bfhi(hi.z), bflo(hi.w), bfhi(hi.w)};
    float r1[8], r2[8];
#pragma unroll
    for (int i = 0; i < 8; ++i) { r1[i] = a[i] * cs[i].x - c[i] * cs[i].y; r2[i] = a[i] * cs[i].y + c[i] * cs[i].x; }
    olo = (u32x4){pk2(r1[0], r1[1]), pk2(r1[2], r1[3]), pk2(r1[4], r1[5]), pk2(r1[6], r1[7])};
    ohi = (u32x4){pk2(r2[0], r2[1]), pk2(r2[2], r2[3]), pk2(r2[4], r2[5]), pk2(r2[6], r2[7])};
}
#define AS_BF8(v) __builtin_bit_cast(bf16x8, v)


constexpr int GM_STRIDE = 288;
__device__ __forceinline__ void gm_ln_load(const P& p, int tok0, int g, int wave, int lane, u32x4 (&raw)[4]) {
    const bf16* PR = (const bf16*)(p.ws + WS_PROJ);
    const int cl = lane & 15;
#pragma unroll
    for (int ps = 0; ps < 4; ++ps) { const int j = 16 * wave + 4 * ps + (lane >> 4); raw[ps] = *(const u32x4*)(PR + (size_t)(tok0 + j) * NPROJ + C_V + g * 128 + 8 * cl); }
}
__device__ __forceinline__ void gm_ln_write(const P& p, LAS unsigned char* img, int g, int wave, int lane, const u32x4 (&rawv)[4]) {
    const int cl = lane & 15;
    const f32x4 ga = *(const f32x4*)(p.v_norm_g + g * 128 + 8 * cl), gb = *(const f32x4*)(p.v_norm_g + g * 128 + 8 * cl + 4);
    const f32x4 ba = *(const f32x4*)(p.v_norm_b + g * 128 + 8 * cl), bb = *(const f32x4*)(p.v_norm_b + g * 128 + 8 * cl + 4);
#pragma unroll
    for (int ps = 0; ps < 4; ++ps) {
        const int j = 16 * wave + 4 * ps + (lane >> 4);
        const u32x4 raw = rawv[ps];
        float v[8] = {bflo(raw.x), bfhi(raw.x), bflo(raw.y), bfhi(raw.y), bflo(raw.z), bfhi(raw.z), bflo(raw.w), bfhi(raw.w)};
        float sm = ((v[0] + v[1]) + (v[2] + v[3])) + ((v[4] + v[5]) + (v[6] + v[7]));
        sm = row16_sum(sm);
        const float mu = sm * (1.f / 128.f);
        float q = 0.f;
#pragma unroll
        for (int i = 0; i < 8; ++i) { v[i] -= mu; q += v[i] * v[i]; }
        q = row16_sum(q);
        const float rs = __builtin_amdgcn_rsqf(q * (1.f / 128.f) + EPS);
        u32x4 o;
        o.x = pk2(v[0] * rs * ga.x + ba.x, v[1] * rs * ga.y + ba.y); o.y = pk2(v[2] * rs * ga.z + ba.z, v[3] * rs * ga.w + ba.w);
        o.z = pk2(v[4] * rs * gb.x + bb.x, v[5] * rs * gb.y + bb.y); o.w = pk2(v[6] * rs * gb.z + bb.z, v[7] * rs * gb.w + bb.w);
        *(LAS u32x4*)(img + j * GM_STRIDE + 16 * cl) = o;
    }
}
__device__ __forceinline__ void ph_gmlp_kv(const P& p, LAS unsigned char* lds) {
    const int tid = otid(), lane = tid & 63, wave = __builtin_amdgcn_readfirstlane(tid >> 6), fr = lane & 15, fq = lane >> 4;
    const bf16* PR = (const bf16*)(p.ws + WS_PROJ); const bf16* WSP = (const bf16*)(p.ws + WS_WSP); bf16* Y = (bf16*)(p.ws + WS_Y);
    for (int u = blockIdx.x; u < NB * 32; u += gridDim.x) {
        const int tok0 = u * 128;
        const int irow = 16 * wave + fr;
        const size_t tokr = (size_t)(tok0 + irow);
        const int ns = (wave < 4) ? 2 : 4;
        float ssq = 0.f;
        u32x4 raw[4]; u32x2 uu[8], un[8]; u32x4 wf[4], wn[4];
#define GM_LOAD_U(dst, g) do { _Pragma("unroll") for (int ct = 0; ct < 8; ++ct) dst[ct] = *(const u32x2*)(PR + tokr * NPROJ + C_U + (g) * 128 + 16 * ct + 4 * fq); } while (0)
#define GM_LOAD_W(dst, g) do { _Pragma("unroll") for (int s4 = 0; s4 < 4; ++s4) if (s4 < ns) { const bf16* wp = WSP + (size_t)(g) * 16384 + (size_t)irow * 128 + 32 * s4 + 4 * fq; \
            const u32x2 w0 = *(const u32x2*)wp, w1 = *(const u32x2*)(wp + 16); dst[s4] = (u32x4){w0.x, w0.y, w1.x, w1.y}; } } while (0)
        __syncthreads();
        gm_ln_load(p, tok0, 0, wave, lane, raw); GM_LOAD_U(uu, 0); GM_LOAD_W(wf, 0);
        gm_ln_write(p, lds, 0, wave, lane, raw);
#pragma unroll 1
        for (int g = 0; g < 8; ++g) {
            LAS unsigned char* img = lds + (g & 1) * (128 * GM_STRIDE);
            asm volatile("s_waitcnt lgkmcnt(0)" ::: "memory");
            __syncthreads();
            if (g < 7) { gm_ln_load(p, tok0, g + 1, wave, lane, raw); GM_LOAD_U(un, g + 1); GM_LOAD_W(wn, g + 1); }
            f32x4 acc[8];
#pragma unroll
            for (int ct = 0; ct < 8; ++ct) acc[ct] = (f32x4){0.f, 0.f, 0.f, 0.f};
            const unsigned ibase = (unsigned)(size_t)img;
            const int q = (lane & 15) >> 2, pp = lane & 3;
#pragma unroll
            for (int s4 = 0; s4 < 4; ++s4) if (s4 < ns) {
                const unsigned r0 = ibase + (unsigned)((32 * s4 + 4 * fq + q) * GM_STRIDE + 8 * pp), r1 = r0 + 16 * GM_STRIDE;
#pragma unroll
                for (int c4 = 0; c4 < 2; ++c4) {
                    u32x2 x0[4], x1[4]; ds_read_tr16x8(r0 + 128 * c4, r1 + 128 * c4, x0, x1);
#pragma unroll
                    for (int c = 0; c < 4; ++c) { const u32x4 av = {x0[c].x, x0[c].y, x1[c].x, x1[c].y};
                        acc[4 * c4 + c] = __builtin_amdgcn_mfma_f32_16x16x32_bf16(AS_BF8(av), AS_BF8(wf[s4]), acc[4 * c4 + c], 0, 0, 0); }
                }
            }
            const float bias = p.b_sp[g * 128 + irow];
#pragma unroll
            for (int ct = 0; ct < 8; ++ct) {
                const u32x2 ur = uu[ct];
                const float y0 = bflo(ur.x) * (acc[ct].x + bias), y1 = bfhi(ur.x) * (acc[ct].y + bias), y2 = bflo(ur.y) * (acc[ct].z + bias), y3 = bfhi(ur.y) * (acc[ct].w + bias);
                ssq += (y0 * y0 + y1 * y1) + (y2 * y2 + y3 * y3);
                { int q8 = __builtin_amdgcn_cvt_pk_fp8_f32(4.f * y0, 4.f * y1, 0, false); q8 = __builtin_amdgcn_cvt_pk_fp8_f32(4.f * y2, 4.f * y3, q8, true);
                  *(unsigned*)((unsigned char*)(p.ws + WS_Y8) + tokr * DM + g * 128 + 16 * ct + 4 * fq) = (unsigned)q8; }
            }
            if (g < 7) { gm_ln_write(p, lds + ((g + 1) & 1) * (128 * GM_STRIDE), g + 1, wave, lane, raw);
#pragma unroll
                for (int ct = 0; ct < 8; ++ct) uu[ct] = un[ct];
#pragma unroll
                for (int s4 = 0; s4 < 4; ++s4) wf[s4] = wn[s4]; }
        }
#undef GM_LOAD_U
#undef GM_LOAD_W
        ssq += __shfl_xor(ssq, 16); ssq += __shfl_xor(ssq, 32);
        const float rsa = __builtin_amdgcn_rsqf(ssq * (1.f / 1024.f) + EPS);
        if (fq == 0) ((float*)(p.ws + WS_SSQ))[tokr] = rsa * 0.25f;
        {
            const bf16* WU = (const bf16*)(p.ws + WS_WUKV);
            bf16* KB = (bf16*)(p.ws + WS_KB); bf16* VB = (bf16*)(p.ws + WS_VB); bf16* KI = (bf16*)(p.ws + WS_KIDX);
            const f32x2* CS = (const f32x2*)(p.ws + WS_CS);
            const size_t tok = tokr;
            bf16x8 af[8]; float sq = 0.f;
#pragma unroll
            for (int s8 = 0; s8 < 8; ++s8) { const u32x4 t = *(const u32x4*)(PR + tok * NPROJ + C_CKV + 32 * s8 + 8 * fq); af[s8] = AS_BF8(t);
                const float e0 = bflo(t.x), e1 = bfhi(t.x), e2 = bflo(t.y), e3 = bfhi(t.y), e4 = bflo(t.z), e5 = bfhi(t.z), e6 = bflo(t.w), e7 = bfhi(t.w);
                sq += ((e0 * e0 + e1 * e1) + (e2 * e2 + e3 * e3)) + ((e4 * e4 + e5 * e5) + (e6 * e6 + e7 * e7)); }
            sq += __shfl_xor(sq, 16); sq += __shfl_xor(sq, 32);
            const float rs = __builtin_amdgcn_rsqf(sq * (1.f / 256.f) + EPS);
            f32x4 o[8];
#pragma unroll
            for (int nt = 0; nt < 8; ++nt) { o[nt] = (f32x4){0.f, 0.f, 0.f, 0.f};
                unsigned woff = (unsigned)((16 * nt + fr) * 256 + 8 * fq) * 2u; asm volatile("" : "+v"(woff));
                const char* wb = (const char*)WU + woff;
#pragma unroll
                for (int s8 = 0; s8 < 8; ++s8) { const bf16x8 wv = *(const bf16x8*)(wb + 64 * s8);
                    o[nt] = __builtin_amdgcn_mfma_f32_16x16x32_bf16(wv, af[s8], o[nt], 0, 0, 0); }
                o[nt] = o[nt] * rs; __builtin_amdgcn_sched_barrier(0); }
#pragma unroll
            for (int nt = 0; nt < 2; ++nt) {
                const f32x4 c01 = *(const f32x4*)(CS + tok * 32 + 16 * nt + 4 * fq), c23 = *(const f32x4*)(CS + tok * 32 + 16 * nt + 4 * fq + 2);
                const f32x4 x1 = o[nt], x2 = o[nt + 2];
                const f32x4 cs = {c01.x, c01.z, c23.x, c23.z}, sn = {c01.y, c01.w, c23.y, c23.w};
                const f32x4 r1 = x1 * cs - x2 * sn, r2 = x1 * sn + x2 * cs;
                *(u32x2*)(KB + tok * 64 + 16 * nt + 4 * fq) = (u32x2){pk2(r1.x, r1.y), pk2(r1.z, r1.w)};
                *(u32x2*)(KB + tok * 64 + 32 + 16 * nt + 4 * fq) = (u32x2){pk2(r2.x, r2.y), pk2(r2.z, r2.w)};
            }
#pragma unroll
            for (int nt = 4; nt < 8; ++nt) *(u32x2*)(VB + tok * 64 + 16 * (nt - 4) + 4 * fq) = (u32x2){pk2(o[nt].x, o[nt].y), pk2(o[nt].z, o[nt].w)};
            {
                const u32x4 lo = *(const u32x4*)(PR + tok * NPROJ + C_KI + 8 * fq), hi = *(const u32x4*)(PR + tok * NPROJ + C_KI + 32 + 8 * fq);
                float a[8] = {bflo(lo.x), bfhi(lo.x), bflo(lo.y), bfhi(lo.y), bflo(lo.z), bfhi(lo.z), bflo(lo.w), bfhi(lo.w)};
                float c[8] = {bflo(hi.x), bfhi(hi.x), bflo(hi.y), bfhi(hi.y), bflo(hi.z), bfhi(hi.z), bflo(hi.w), bfhi(hi.w)};
                float s2 = 0.f;
#pragma unroll
                for (int i = 0; i < 8; ++i) s2 += a[i] * a[i] + c[i] * c[i];
                s2 += __shfl_xor(s2, 16); s2 += __shfl_xor(s2, 32);
                const float r = __builtin_amdgcn_rsqf(s2 * (1.f / 64.f) + EPS);
                float r1[8], r2[8];
#pragma unroll
                for (int i = 0; i < 8; ++i) { const f32x2 cs = CS[tok * 32 + 8 * fq + i];
                    const float x1 = a[i] * r * p.kidx_norm_g[8 * fq + i], x2 = c[i] * r * p.kidx_norm_g[32 + 8 * fq + i];
                    r1[i] = x1 * cs.x - x2 * cs.y; r2[i] = x1 * cs.y + x2 * cs.x; }
                *(u32x4*)(KI + tok * 64 + 8 * fq) = (u32x4){pk2(r1[0], r1[1]), pk2(r1[2], r1[3]), pk2(r1[4], r1[5]), pk2(r1[6], r1[7])};
                *(u32x4*)(KI + tok * 64 + 32 + 8 * fq) = (u32x4){pk2(r2[0], r2[1]), pk2(r2[2], r2[3]), pk2(r2[4], r2[5]), pk2(r2[6], r2[7])};
            }
        }
    }
}

__device__ __forceinline__ void ph_attn(const P& p, LAS unsigned char* lds) {
    const int tid = otid(), lane0 = tid & 63, wave = __builtin_amdgcn_readfirstlane(tid >> 6);
    const bf16* PR = (const bf16*)(p.ws + WS_PROJ);
    const bf16* KB = (const bf16*)(p.ws + WS_KB); const bf16* VB = (const bf16*)(p.ws + WS_VB); const bf16* KI = (const bf16*)(p.ws + WS_KIDX);
    const f32x2* CS = (const f32x2*)(p.ws + WS_CS);
    bf16* Y = (bf16*)(p.ws + WS_Y);
    unsigned* const SCRa = (unsigned*)(p.ws + WS_SCR) + (size_t)blockIdx.x * (16 * 4096); unsigned* const SCRb = (unsigned*)(p.ws + WS_SCR2) + (size_t)blockIdx.x * (16 * 4096);
    LAS unsigned char* wl = lds + wave * 10240;
    LAS int* sel = (LAS int*)(wl + 9216);
    const unsigned vbase = (unsigned)(size_t)wl;
    const int cx = blockIdx.x & 7, cj = blockIdx.x >> 3;
    constexpr int AQ_OFF = 8 * 10240;
#define AT_BLK(R) (255 - (AT_NA * (R) + (((R) & 1) ? (AT_NA - 1 - cj) : cj)))
#define AQ_PRODUCE(RR) do { const int _blk = AT_BLK(RR); \
        if (_blk >= 0 && (((16 * _blk) >> 6) + 1) * 64 > 256) { \
            int _l = lane0; asm volatile("" : "+v"(_l)); const int _fr = _l & 15, _fq = _l >> 4; const int _tok = cx * SEQ + 16 * _blk + _fr; \
            f32x2 _cs[8]; const f32x4* _csp = (const f32x4*)(CS + (size_t)_tok * 32 + 8 * _fq); \
            _Pragma("unroll") for (int _i = 0; _i < 4; ++_i) { const f32x4 _t = _csp[_i]; _cs[2 * _i] = (f32x2){_t.x, _t.y}; _cs[2 * _i + 1] = (f32x2){_t.z, _t.w}; } \
            const bf16* _src = PR + (size_t)_tok * NPROJ + C_QI + wave * 64 + 8 * _fq; \
            const u32x4 _lo = *(const u32x4*)_src, _hi = *(const u32x4*)(_src + 32); u32x4 _olo, _ohi; rope8(_lo, _hi, _cs, _olo, _ohi); \
            LAS unsigned char* _ab = lds + AQ_OFF + ((RR) & 1) * 16384 + _l * 16; \
            *(LAS u32x4*)(_ab + (2 * wave) * 1024) = _olo; *(LAS u32x4*)(_ab + (2 * wave + 1) * 1024) = _ohi; } } while (0)
    LAS unsigned* const qctr = (LAS unsigned*)(lds + 114688);
    if (tid == 0) { qctr[0] = 0u; qctr[1] = 0u; }
    AQ_PRODUCE(0);
    asm volatile("s_waitcnt lgkmcnt(0)" ::: "memory");
    __syncthreads();
    for (int rr = 0; rr < 9; ++rr) {
        const int blk = AT_BLK(rr);
        if (blk < 0) break;
        unsigned* const SCR = (rr & 1) ? SCRb : SCRa;
        const int b = cx, tok0 = b * SEQ + 16 * blk;
        const int nadm = (((16 * blk) >> 6) + 1) << 6;
        const size_t kb0 = (size_t)b * SEQ;
        if (nadm > 256) {
            int lane = lane0; asm volatile("" : "+v"(lane)); const int fr = lane & 15, fq = lane >> 4;
            bf16x8 Aq[8][2];
            {
                const LAS unsigned char* ab = lds + AQ_OFF + (rr & 1) * 16384 + lane * 16;
#pragma unroll
                for (int h = 0; h < 8; ++h) { Aq[h][0] = *(const LAS bf16x8*)(ab + (2 * h) * 1024); Aq[h][1] = *(const LAS bf16x8*)(ab + (2 * h + 1) * 1024); }
            }
            float wq[4][8];
#pragma unroll
            for (int j = 0; j < 4; ++j) { const u32x4 t = *(const u32x4*)(PR + (size_t)(tok0 + 4 * fq + j) * NPROJ + C_WI);
                wq[j][0] = bflo(t.x) * 0.04419417382415922f; wq[j][1] = bfhi(t.x) * 0.04419417382415922f; wq[j][2] = bflo(t.y) * 0.04419417382415922f; wq[j][3] = bfhi(t.y) * 0.04419417382415922f;
                wq[j][4] = bflo(t.z) * 0.04419417382415922f; wq[j][5] = bfhi(t.z) * 0.04419417382415922f; wq[j][6] = bflo(t.w) * 0.04419417382415922f; wq[j][7] = bfhi(t.w) * 0.04419417382415922f; }
            const int nkt = nadm >> 4, ng = (nkt - wave + 7) >> 3;
            const bf16* kp = KI + (kb0 + 16 * wave + fr) * 64 + 8 * fq;
            bf16x8 rb[8][2];
#pragma unroll
            for (int i = 0; i < 8; ++i) asm volatile("" : "=v"(rb[i][0]), "=v"(rb[i][1]));
#define SC_TILE(i, kt) do { \
                    f32x4 sc = {0.f, 0.f, 0.f, 0.f}; f32x4 ah[8]; \
                    _Pragma("unroll") for (int h = 0; h < 8; ++h) ah[h] = __builtin_amdgcn_mfma_f32_16x16x32_bf16(Aq[h][0], rb[i][0], (f32x4){0.f, 0.f, 0.f, 0.f}, 0, 0, 0); \
                    _Pragma("unroll") for (int h = 0; h < 8; ++h) ah[h] = __builtin_amdgcn_mfma_f32_16x16x32_bf16(Aq[h][1], rb[i][1], ah[h], 0, 0, 0); \
                    _Pragma("unroll") for (int h = 0; h < 8; ++h) { const f32x4 acc = ah[h]; \
                        sc.x += wq[0][h] * relu_i(acc.x); sc.y += wq[1][h] * relu_i(acc.y); sc.z += wq[2][h] * relu_i(acc.z); sc.w += wq[3][h] * relu_i(acc.w); } \
                    if (sc.x == 0.f) sc.x = 0.f; if (sc.y == 0.f) sc.y = 0.f; if (sc.z == 0.f) sc.z = 0.f; if (sc.w == 0.f) sc.w = 0.f; \
                    scx = sc; } while (0)
#define SC_STORE(kt) do { unsigned* sp = SCR + (size_t)(4 * fq) * 4096 + 16 * (kt) + fr; \
                    sp[0] = sortkey(scx.x); sp[4096] = sortkey(scx.y); sp[2 * 4096] = sortkey(scx.z); sp[3 * 4096] = sortkey(scx.w); } while (0)
#define SC_ALOAD(i, ptr) asm volatile("global_load_dwordx4 %0, %2, off sc1\n\tglobal_load_dwordx4 %1, %2, off offset:64 sc1" : "=&v"(rb[i][0]), "=&v"(rb[i][1]) : "v"(ptr) : "memory")
#define SC_AWAIT(i, n) asm volatile("s_waitcnt vmcnt(" #n ")" : "+v"(rb[i][0]), "+v"(rb[i][1]) :: "memory")
            f32x4 scx;
            if (ng >= 16) {
#pragma unroll
                for (int i = 0; i < 8; ++i) { const bf16* q = kp + (size_t)i * 8192; SC_ALOAD(i, q); }
#define SC_FIRST(i, n) do { SC_AWAIT(i, n); SC_TILE(i, wave + 8 * (i)); { const bf16* q = kp + (size_t)(8 + (i)) * 8192; SC_ALOAD(i, q); } SC_STORE(wave + 8 * (i)); } while (0)
                SC_FIRST(0, 14); SC_FIRST(1, 18); SC_FIRST(2, 22); SC_FIRST(3, 26); SC_FIRST(4, 30); SC_FIRST(5, 34); SC_FIRST(6, 38); SC_FIRST(7, 42);
#undef SC_FIRST
                for (int g0 = 8; g0 < ng; g0 += 8) {
#pragma unroll
                    for (int i = 0; i < 8; ++i) if (g0 + i < ng) {
                        SC_AWAIT(i, 32);
                        SC_TILE(i, wave + 8 * (g0 + i));
                        if (g0 + 8 + i < ng) { const bf16* q = kp + (size_t)(g0 + 8 + i) * 8192; SC_ALOAD(i, q); }
                        SC_STORE(wave + 8 * (g0 + i));
                    }
                }
            } else {
#pragma unroll
                for (int i = 0; i < 8; ++i) if (i < ng) { rb[i][0] = *(const bf16x8*)(kp + (size_t)i * 8192); rb[i][1] = *(const bf16x8*)(kp + (size_t)i * 8192 + 32); }
                for (int g0 = 0; g0 < ng; g0 += 8) {
#pragma unroll
                    for (int i = 0; i < 8; ++i) if (g0 + i < ng) {
                        SC_TILE(i, wave + 8 * (g0 + i));
                        if (g0 + 8 + i < ng) { rb[i][0] = *(const bf16x8*)(kp + (size_t)(g0 + 8 + i) * 8192); rb[i][1] = *(const bf16x8*)(kp + (size_t)(g0 + 8 + i) * 8192 + 32); }
                        SC_STORE(wave + 8 * (g0 + i));
                    }
                }
            }
#undef SC_TILE
#undef SC_STORE
#undef SC_ALOAD
#undef SC_AWAIT
            AQ_PRODUCE(rr + 1);
            { const int tail = ((nadm + 511) & ~511) - nadm; for (int i = tid; i < 16 * tail; i += 512) SCR[(size_t)(i / tail) * 4096 + nadm + (i % tail)] = 0u; }
            asm volatile("s_waitcnt vmcnt(0) lgkmcnt(0)" ::: "memory");
        }
        __syncthreads();
        if (tid == 0) qctr[(rr + 1) & 1] = 0u;
        for (;;) {
            unsigned qt = 0u; if (lane0 == 0) qt = __hip_atomic_fetch_add(&qctr[rr & 1], 1u, __ATOMIC_RELAXED, __HIP_MEMORY_SCOPE_WORKGROUP);
            const int qi = __builtin_amdgcn_readfirstlane((int)qt);
            if (qi >= 16) break;
            const int tok = tok0 + qi;
            int lane = lane0; asm volatile("" : "+v"(lane));
            int nvalid;
            if (nadm <= 256) { for (int s = lane; s < nadm; s += 64) sel[s] = s; nvalid = nadm; }
            else {
                unsigned K[64];
                const u32x4* sp = (const u32x4*)(SCR + (size_t)qi * 4096) + lane;
                {
                    u32x4 t[16];
#pragma unroll
                    for (int g = 0; g < 8; ++g) {
                        if (512 * g < nadm) {
#pragma unroll
                            for (int r4 = 0; r4 < 2; ++r4) { const u32x4* q = sp + 64 * (2 * g + r4); asm volatile("global_load_dwordx4 %0, %1, off sc1" : "=&v"(t[2 * g + r4]) : "v"(q) : "memory"); }
                        } else { t[2 * g] = (u32x4){0u, 0u, 0u, 0u}; t[2 * g + 1] = (u32x4){0u, 0u, 0u, 0u}; }
                    }
                    asm volatile("s_waitcnt vmcnt(0)" : "+v"(t[0]), "+v"(t[1]), "+v"(t[2]), "+v"(t[3]), "+v"(t[4]), "+v"(t[5]), "+v"(t[6]), "+v"(t[7]),
                                 "+v"(t[8]), "+v"(t[9]), "+v"(t[10]), "+v"(t[11]), "+v"(t[12]), "+v"(t[13]), "+v"(t[14]), "+v"(t[15]) :: "memory");
#pragma unroll
                    for (int i = 0; i < 16; ++i) { K[4 * i] = t[i].x; K[4 * i + 1] = t[i].y; K[4 * i + 2] = t[i].z; K[4 * i + 3] = t[i].w; }
                }
                unsigned prefix = 0u; int chi = 0, tge = nadm;
                for (int bit = 31; bit >= 18; --bit) {
                    const unsigned cand = prefix | (1u << bit); int cnt = 0;
#pragma unroll
                    for (int g = 0; g < 8; ++g) if (512 * g < nadm) {
                        cnt += cnt_ge8(K, g, cand);
                    }
                    if (cnt >= 256) { prefix = cand; tge = cnt; } else chi = cnt;
                }
                LAS unsigned* bl = (LAS unsigned*)wl;
                {
                    int bc = 0;
#pragma unroll
                    for (int g = 0; g < 8; ++g) if (512 * g < nadm) {
#pragma unroll
                        for (int r8 = 0; r8 < 8; ++r8) { const unsigned k = K[8 * g + r8]; const bool inb = (k - prefix) < 0x40000u;
                            if (__ballot(inb) != 0ull) { if (inb) { if (bc < 4) bl[bc * 64 + lane] = k; ++bc; } } }
                    }
                    if (__ballot(bc > 4) == 0ull) {
                        asm volatile("s_waitcnt lgkmcnt(0)" ::: "memory");
                        const unsigned B0 = (bc > 0) ? bl[lane] : 0u, B1 = (bc > 1) ? bl[64 + lane] : 0u, B2 = (bc > 2) ? bl[128 + lane] : 0u, B3 = (bc > 3) ? bl[192 + lane] : 0u;
                        for (int bit = 17; bit >= 0; --bit) {
                            const unsigned cand = prefix | (1u << bit);
                            const int cnt = chi + __popcll(__ballot(B0 >= cand)) + __popcll(__ballot(B1 >= cand)) + __popcll(__ballot(B2 >= cand)) + __popcll(__ballot(B3 >= cand));
                            if (cnt >= 256) { prefix = cand; tge = cnt; }
                        }
                    } else {
                        for (int bit = 17; bit >= 0; --bit) {
                            const unsigned cand = prefix | (1u << bit); int cnt = 0;
#pragma unroll
                            for (int g = 0; g < 8; ++g) if (512 * g < nadm) {
                                cnt += cnt_ge8(K, g, cand);
                            }
                            if (cnt >= 256) { prefix = cand; tge = cnt; }
                        }
                    }
                    asm volatile("s_waitcnt lgkmcnt(0)" ::: "memory");
                }
                bool done = false;
                if (tge == 256) {
                    int base = 0;
#pragma unroll
                    for (int g = 0; g < 8; ++g) if (512 * g < nadm) {
#pragma unroll
                        for (int r8 = 0; r8 < 8; ++r8) { const bool ge = K[8 * g + r8] >= prefix; const unsigned long long m = __ballot(ge);
                            if (ge) sel[base + (int)mbcnt64(m)] = 256 * ((8 * g + r8) >> 2) + 4 * lane + (r8 & 3);
                            base += __popcll(m); }
                    }
                    done = true;
                }
                if (!done) {
                int cgt = 0;
#pragma unroll
                for (int g = 0; g < 8; ++g) if (512 * g < nadm) {
#pragma unroll
                    for (int r8 = 0; r8 < 8; ++r8) cgt += __popcll(__ballot(K[8 * g + r8] > prefix));
                }
                const int need = 256 - cgt;
                int bgt = 0, beq = 0;
#pragma unroll
                for (int rr4 = 0; rr4 < 16; ++rr4) if (256 * rr4 < nadm) {
                    unsigned long long me[4]; int below = 0;
#pragma unroll
                    for (int i = 0; i < 4; ++i) { me[i] = __ballot(K[4 * rr4 + i] == prefix); below += (int)mbcnt64(me[i]); }
#pragma unroll
                    for (int i = 0; i < 4; ++i) { const int r = 4 * rr4 + i;
                        const bool gt = K[r] > prefix, eq = K[r] == prefix;
                        const unsigned long long mg = __ballot(gt);
                        const int pg = bgt + (int)mbcnt64(mg);
                        int same = 0;
#pragma unroll
                        for (int i2 = 0; i2 < 4; ++i2) if (i2 < i) same += (int)((me[i2] >> lane) & 1ull);
                        const int pe = beq + below + same;
                        if (gt) sel[pg] = 256 * rr4 + 4 * lane + i;
                        if (eq && pe < need) sel[cgt + pe] = 256 * rr4 + 4 * lane + i;
                        bgt += __popcll(mg); }
                    beq += __popcll(me[0]) + __popcll(me[1]) + __popcll(me[2]) + __popcll(me[3]);
                }
                }
                nvalid = 256;
            }
            asm volatile("s_waitcnt lgkmcnt(0)" ::: "memory");
            asm volatile("" : "+v"(lane)); const int fr = lane & 15, fq = lane >> 4;
            bf16x8 Bq0, Bq1;
            {
                f32x2 cs[8];
                const f32x4* csp = (const f32x4*)(CS + (size_t)tok * 32 + 8 * fq);
#pragma unroll
                for (int i = 0; i < 4; ++i) { const f32x4 t = csp[i]; cs[2 * i] = (f32x2){t.x, t.y}; cs[2 * i + 1] = (f32x2){t.z, t.w}; }
                const bf16* src = PR + (size_t)tok * NPROJ + C_Q + fr * 64 + 8 * fq;
                const u32x4 lo = *(const u32x4*)src, hi = *(const u32x4*)(src + 32);
                u32x4 olo, ohi; rope8(lo, hi, cs, olo, ohi);
                Bq0 = AS_BF8(olo); Bq1 = AS_BF8(ohi);
            }
            f32x4 S[16];
            {
                bf16x8 ka[16][2];
#pragma unroll
                for (int i = 0; i < 16; ++i) { int idx = sel[16 * i + fr]; idx = (16 * i + fr < nvalid) ? idx : 0; const bf16* kp = KB + (kb0 + idx) * 64 + 8 * fq; ka[i][0] = *(const bf16x8*)kp; ka[i][1] = *(const bf16x8*)(kp + 32); }
#pragma unroll
                for (int i = 0; i < 16; ++i) { f32x4 acc = {0.f, 0.f, 0.f, 0.f};
                    acc = __builtin_amdgcn_mfma_f32_16x16x32_bf16(ka[i][0], Bq0, acc, 0, 0, 0);
                    acc = __builtin_amdgcn_mfma_f32_16x16x32_bf16(ka[i][1], Bq1, acc, 0, 0, 0);
                    S[i] = acc; }
            }
            u32x4 va[8], vb[8], vc[8];
#define LOADV(dst, ch) do { _Pragma("unroll") for (int _i = 0; _i < 8; ++_i) { const int _sl = 64 * (ch) + 8 * _i + (lane >> 3); int _ix = sel[_sl]; _ix = (_sl < nvalid) ? _ix : 0; \
                dst[_i] = *(const u32x4*)(VB + (kb0 + _ix) * 64 + 8 * (lane & 7)); } } while (0)
            LOADV(va, 0); LOADV(vb, 1);
            const float SCL = 0.125f * 1.4426950408889634f;
            float mx = -INFINITY;
            if (nvalid < 256) {
#pragma unroll
                for (int t = 0; t < 16; ++t)
#pragma unroll
                    for (int j = 0; j < 4; ++j) S[t][j] = (16 * t + 4 * fq + j < nvalid) ? S[t][j] : -INFINITY;
            }
            f32x4 m4 = {-INFINITY, -INFINITY, -INFINITY, -INFINITY};
#pragma unroll
            for (int t = 0; t < 16; ++t) { const f32x4 v = S[t] * SCL; S[t] = v; m4.x = fmaxf(m4.x, v.x); m4.y = fmaxf(m4.y, v.y); m4.z = fmaxf(m4.z, v.z); m4.w = fmaxf(m4.w, v.w); }
            mx = fmaxf(mx, fmaxf(fmaxf(m4.x, m4.y), fmaxf(m4.z, m4.w)));
            mx = fmaxf(mx, __shfl_xor(mx, 16)); mx = fmaxf(mx, __shfl_xor(mx, 32));
            f32x4 s4 = {0.f, 0.f, 0.f, 0.f};
#pragma unroll
            for (int t = 0; t < 16; ++t) { const f32x4 d = S[t] - mx; const f32x4 e = {__builtin_amdgcn_exp2f(d.x), __builtin_amdgcn_exp2f(d.y), __builtin_amdgcn_exp2f(d.z), __builtin_amdgcn_exp2f(d.w)}; S[t] = e; s4 += e; }
            float sum = (s4.x + s4.y) + (s4.z + s4.w);
            sum += __shfl_xor(sum, 16); sum += __shfl_xor(sum, 32);
            const float inv = __builtin_amdgcn_rcpf(sum);
            bf16x8 Pk[8];
#pragma unroll
            for (int t2 = 0; t2 < 8; ++t2) { const f32x4 pa = S[2 * t2] * inv, pb = S[2 * t2 + 1] * inv; const u32x4 pw = {pk2(pa.x, pa.y), pk2(pa.z, pa.w), pk2(pb.x, pb.y), pk2(pb.z, pb.w)}; Pk[t2] = AS_BF8(pw); }
            f32x4 Oc[4];
#pragma unroll
            for (int c = 0; c < 4; ++c) Oc[c] = (f32x4){0.f, 0.f, 0.f, 0.f};
#define PVCHUNK(src, ch, NEXT) do { \
                _Pragma("unroll") for (int _i = 0; _i < 8; ++_i) *(LAS u32x4*)(wl + (8 * _i + (lane >> 3)) * 144 + 16 * (lane & 7)) = src[_i]; \
                NEXT; \
                asm volatile("s_waitcnt lgkmcnt(0)" ::: "memory"); \
                _Pragma("unroll") for (int tl = 0; tl < 2; ++tl) { \
                    const bf16x8 Ap = Pk[2 * (ch) + tl]; \
                    const unsigned r0 = vbase + (unsigned)((32 * tl + 4 * fq + ((lane & 15) >> 2)) * 144 + 8 * (lane & 3)), r1 = r0 + 16 * 144; \
                    u32x2 x0[4], x1[4]; ds_read_tr16x8(r0, r1, x0, x1); \
                    _Pragma("unroll") for (int c = 0; c < 4; ++c) { const u32x4 bw = {x0[c].x, x0[c].y, x1[c].x, x1[c].y}; \
                        Oc[c] = __builtin_amdgcn_mfma_f32_16x16x32_bf16(AS_BF8(bw), Ap, Oc[c], 0, 0, 0); } \
                } \
                asm volatile("s_waitcnt lgkmcnt(0)" ::: "memory"); } while (0)
            LOADV(vc, 2);
            PVCHUNK(va, 0, LOADV(va, 3));
            PVCHUNK(vb, 1, (void)0);
            PVCHUNK(vc, 2, (void)0);
            PVCHUNK(va, 3, (void)0);
#undef PVCHUNK
#undef LOADV
            float ss = 0.f;
#pragma unroll
            for (int c = 0; c < 4; ++c) ss += Oc[c].x * Oc[c].x + Oc[c].y * Oc[c].y + Oc[c].z * Oc[c].z + Oc[c].w * Oc[c].w;
            const float rs = __builtin_amdgcn_rsqf(wave_sum(ss) * (1.f / 1024.f) + EPS) * __builtin_amdgcn_rcpf(((const float*)(p.ws + WS_SSQ))[tok]);
#pragma unroll
            for (int c = 0; c < 4; ++c) { int q8 = __builtin_amdgcn_cvt_pk_fp8_f32(Oc[c].x * rs, Oc[c].y * rs, 0, false); q8 = __builtin_amdgcn_cvt_pk_fp8_f32(Oc[c].z * rs, Oc[c].w * rs, q8, true);
                *(unsigned*)((unsigned char*)(p.ws + WS_Y8) + (size_t)tok * DM + 1024 + fr * 64 + 16 * c + 4 * fq) = (unsigned)q8; }
        }
    }
}

constexpr int RT_STRIDE = 4112;
__device__ __forceinline__ void ph_route(const P& p, LAS unsigned char* lds) {
    const int tid = otid(), lane = tid & 63, wave = __builtin_amdgcn_readfirstlane(tid >> 6), fr = lane & 15, fq = lane >> 4;
    const float* mod = (const float*)(p.ws + WS_MOD);
    bf16* H = (bf16*)(p.ws + WS_H); const bf16* WR = (const bf16*)(p.ws + WS_WR);
    unsigned* cnt = (unsigned*)(p.ws + WS_CTL) + CW_CNT;
    int* list = (int*)(p.ws + WS_LIST); u32x4* tokinfo = (u32x4*)(p.ws + WS_TOK);
    LAS unsigned char* img = lds;
    LAS float* part = (LAS float*)(lds + 16 * RT_STRIDE);
    LAS float* logit = part + 8 * 16 * 48;
    LAS unsigned* lcnt = (LAS unsigned*)(logit + 16 * 48);
    LAS u32x4* rinfo = (LAS u32x4*)(lcnt + 64);
    const int ngrp = NT / 16, gpw = (ngrp + gridDim.x - 1) / gridDim.x;
    const int g_lo = blockIdx.x * gpw, g_hi = (g_lo + gpw < ngrp) ? g_lo + gpw : ngrp;
    if (tid < 32) lcnt[tid] = 0u;
    __syncthreads();
    f32x4 gsc[8], shv[8];
    { const int b = (g_lo * 16) >> 12;
#pragma unroll
      for (int j = 0; j < 8; ++j) { const int col = 4 * lane + 256 * j;
          const f32x4 g = *(const f32x4*)(p.norm2_g + col), sh = *(const f32x4*)(mod + b * 12288 + 3 * 2048 + col), sc = *(const f32x4*)(mod + b * 12288 + 4 * 2048 + col);
          gsc[j] = g * (sc + 1.f); shv[j] = sh; } }
    u32x2 xt[2][8];
#define RT_LOADX(G) do { _Pragma("unroll") for (int rr = 0; rr < 2; ++rr) { const u32x2* xr = (const u32x2*)((const bf16*)(p.ws + WS_X1) + (size_t)((G) * 16 + 2 * wave + rr) * DM) + lane; \
        _Pragma("unroll") for (int j = 0; j < 8; ++j) xt[rr][j] = __builtin_nontemporal_load(xr + 64 * j); } } while (0)
    if (g_lo < g_hi) RT_LOADX(g_lo);
    for (int grp = g_lo; grp < g_hi; ++grp) {
#pragma unroll
        for (int rr = 0; rr < 2; ++rr) {
            const int lr = 2 * wave + rr, m = grp * 16 + lr;
            f32x4 v[8]; float ss = 0.f;
#pragma unroll
            for (int j = 0; j < 8; ++j) { const u32x2 t = xt[rr][j]; v[j] = (f32x4){bflo(t.x), bfhi(t.x), bflo(t.y), bfhi(t.y)}; ss += v[j].x * v[j].x + v[j].y * v[j].y + v[j].z * v[j].z + v[j].w * v[j].w; }
            const float rstd = __builtin_amdgcn_rsqf(wave_sum(ss) * (1.f / DM) + EPS);
            unsigned* o = (unsigned*)((unsigned char*)H + (size_t)m * DM) + lane;
#pragma unroll
            for (int j = 0; j < 8; ++j) {
                const int col = 4 * lane + 256 * j;
                const f32x4 h = v[j] * rstd * gsc[j] + shv[j];
                const u32x2 w = {pk2(h.x, h.y), pk2(h.z, h.w)};
                { int q8 = __builtin_amdgcn_cvt_pk_fp8_f32(h.x, h.y, 0, false); q8 = __builtin_amdgcn_cvt_pk_fp8_f32(h.z, h.w, q8, true); o[64 * j] = (unsigned)q8; }
                *(LAS u32x2*)(img + lr * RT_STRIDE + col * 2) = w;
            }
        }
        if (grp + 1 < g_hi) RT_LOADX(grp + 1);
        __syncthreads();
        {
            f32x4 acc[3];
#pragma unroll
            for (int n = 0; n < 3; ++n) acc[n] = (f32x4){0.f, 0.f, 0.f, 0.f};
#pragma unroll
            for (int s8 = 0; s8 < 8; ++s8) {
                const int k0 = 256 * wave + 32 * s8 + 8 * fq;
                const bf16x8 a = *(const LAS bf16x8*)(img + fr * RT_STRIDE + k0 * 2);
#pragma unroll
                for (int n = 0; n < 3; ++n) { const bf16x8 bw = *(const bf16x8*)(WR + (size_t)(16 * n + fr) * DM + k0);
                    acc[n] = __builtin_amdgcn_mfma_f32_16x16x32_bf16(a, bw, acc[n], 0, 0, 0); }
            }
#pragma unroll
            for (int n = 0; n < 3; ++n)
#pragma unroll
                for (int j = 0; j < 4; ++j) part[(wave * 16 + 4 * fq + j) * 48 + 16 * n + fr] = acc[n][j];
        }
        __syncthreads();
        for (int i = tid; i < 16 * 48; i += 512) { float sacc = 0.f;
#pragma unroll
            for (int w = 0; w < 8; ++w) sacc += part[w * 768 + i];
            const int col = i % 48; sacc += (col < 4) ? p.b_group[col] : ((col < 36) ? p.b_expert[col - 4] : 0.f);
            logit[i] = sacc; }
        __syncthreads();
        if (tid < 16) {
            const LAS float* lg = logit + tid * 48;
            int gi = 0; float gm = lg[0];
#pragma unroll
            for (int q = 1; q < 4; ++q) { const float t = lg[q]; if (t > gm) { gm = t; gi = q; } }
            float gs = 0.f;
#pragma unroll
            for (int q = 0; q < 4; ++q) gs += __expf(lg[q] - gm);
            const float gp = __builtin_amdgcn_rcpf(gs);
            const LAS float* el = lg + 4 + 8 * gi;
            int i1 = 0; float m1 = el[0];
#pragma unroll
            for (int q = 1; q < 8; ++q) { const float t = el[q]; if (t > m1) { m1 = t; i1 = q; } }
            int i2 = -1; float m2 = -INFINITY;
#pragma unroll
            for (int q = 0; q < 8; ++q) { const float t = el[q]; if (q != i1 && t > m2) { m2 = t; i2 = q; } }
            const float r2 = __expf(m2 - m1);
            const float w0 = gp * __builtin_amdgcn_rcpf(1.f + r2), w1 = w0 * r2;
            const int e0 = gi * 8 + i1, e1 = gi * 8 + i2;
            const unsigned p0 = __hip_atomic_fetch_add(&lcnt[e0], 1u, __ATOMIC_RELAXED, __HIP_MEMORY_SCOPE_WORKGROUP), p1 = __hip_atomic_fetch_add(&lcnt[e1], 1u, __ATOMIC_RELAXED, __HIP_MEMORY_SCOPE_WORKGROUP);
            rinfo[(grp - g_lo) * 16 + tid] = (u32x4){((unsigned)e0 << 16) | p0, ((unsigned)e1 << 16) | p1, __float_as_uint(w0), __float_as_uint(w1)};
        }
        __syncthreads();
    }
    if (tid < 32) { const unsigned c = lcnt[tid]; lcnt[tid] = c ? atomicAdd(&cnt[tid], c) : 0u; }
    __syncthreads();
    for (int r = tid; r < (g_hi - g_lo) * 16; r += 512) {
        const u32x4 ri = rinfo[r]; const int m = g_lo * 16 + r;
        const unsigned e0 = ri.x >> 16, e1 = ri.y >> 16;
        const unsigned p0 = lcnt[e0] + (ri.x & 0xffffu), p1 = lcnt[e1] + (ri.y & 0xffffu);
        list[(size_t)e0 * NT + p0] = m; list[(size_t)e1 * NT + p1] = m;
        tokinfo[m] = (u32x4){(e0 << 16) | p0, (e1 << 16) | p1, ri.z, ri.w};
    }
}

#undef RT_LOADX
__device__ __forceinline__ void ph_final(const P& p) {
    const int tid = otid(), lane = tid & 63, wave = tid >> 6;
    const int gw = blockIdx.x * 8 + wave, NGW = gridDim.x * 8;
    const unsigned* cnt = (const unsigned*)(p.ws + WS_CTL) + CW_CNT;
    const u32x4* tokinfo = (const u32x4*)(p.ws + WS_TOK); const bf16* YM = (const bf16*)(p.ws + WS_YMOE); const float* mod = (const float*)(p.ws + WS_MOD);
    int myb = 0;
    { int run = 0; for (int e = 0; e < NE; ++e) { if (lane == e) myb = run; run += ((int)cnt[e] + 255) & ~255; } }
    for (int m0 = 2 * gw; m0 < NT; m0 += 2 * NGW) {
        u32x2 xt[2][8]; unsigned ya[2][8], yb[2][8]; float w0[2], w1[2];
#pragma unroll
        for (int r = 0; r < 2; ++r) {
            const int m = m0 + r;
            const u32x4 ti = tokinfo[m];
            const int e0 = ti.x >> 16, p0 = ti.x & 0xffff, e1 = ti.y >> 16, p1 = ti.y & 0xffff;
            const unsigned w0b = ti.z, w1b = ti.w;
            w0[r] = __uint_as_float(w0b); w1[r] = __uint_as_float(w1b);
            const size_t r0 = (size_t)(__shfl(myb, e0) + p0), r1 = (size_t)(__shfl(myb, e1) + p1);
            const u32x2* x1r = (const u32x2*)((const bf16*)(p.ws + WS_X1) + (size_t)m * DM) + lane;
            const unsigned* y0 = (const unsigned*)((const unsigned char*)YM + r0 * DM) + lane; const unsigned* y1 = (const unsigned*)((const unsigned char*)YM + r1 * DM) + lane;
#pragma unroll
            for (int j = 0; j < 8; ++j) { xt[r][j] = x1r[64 * j]; ya[r][j] = y0[64 * j]; yb[r][j] = y1[64 * j]; }
        }
#pragma unroll
        for (int r = 0; r < 2; ++r) {
            const int m = m0 + r, b = m >> 12;
            f32x4* xr = (f32x4*)(p.out + (size_t)m * DM) + lane;
            f32x4 v[8]; float ss = 0.f;
#pragma unroll
            for (int j = 0; j < 8; ++j) {
                const int col = 4 * lane + 256 * j;
                const f32x4 xv = {bflo(xt[r][j].x), bfhi(xt[r][j].x), bflo(xt[r][j].y), bfhi(xt[r][j].y)};
                const unsigned a = ya[r][j], c = yb[r][j];
                const f32x4 g2 = *(const f32x4*)(mod + b * 12288 + 5 * 2048 + col);
                const f32x2 a01 = __builtin_amdgcn_cvt_pk_f32_fp8((int)a, false), a23 = __builtin_amdgcn_cvt_pk_f32_fp8((int)a, true), c01 = __builtin_amdgcn_cvt_pk_f32_fp8((int)c, false), c23 = __builtin_amdgcn_cvt_pk_f32_fp8((int)c, true);
                const f32x4 yav = (f32x4){a01.x, a01.y, a23.x, a23.y} * 0.0625f, ybv = (f32x4){c01.x, c01.y, c23.x, c23.y} * 0.0625f;
                v[j] = xv + g2 * (yav * w0[r] + ybv * w1[r]);
                ss += v[j].x * v[j].x + v[j].y * v[j].y + v[j].z * v[j].z + v[j].w * v[j].w;
            }
            const float rstd = __builtin_amdgcn_rsqf(wave_sum(ss) * (1.f / DM) + EPS);
#pragma unroll
            for (int j = 0; j < 8; ++j) { const int col = 4 * lane + 256 * j; __builtin_nontemporal_store(v[j] * rstd * *(const f32x4*)(p.final_g + col), xr + 64 * j); }
        }
    }
}


__global__ void __launch_bounds__(512, 2) mk_fwd(P p) {
    extern __shared__ __attribute__((aligned(16))) unsigned char lds_raw[];
    LAS unsigned char* lds = (LAS unsigned char*)lds_raw;
    const int lo = p.ph_lo, hi = p.ph_hi;
#ifdef PHSEL
#define IN(k) ((k)==PHSEL && lo <= (k) && (k) < hi)
#else
#define IN(k) (lo <= (k) && (k) < hi)
#endif
#define BOTH(k) (IN(k) && IN((k) + 1))
    if (threadIdx.x < 16) ((LAS unsigned*)(lds + LDS_MISC))[threadIdx.x] = 0u;
    __syncthreads();
    XcdBarrier bar = xcd_barrier_post((unsigned*)(p.ws + WS_CTL) + CW_BAR, (volatile LAS unsigned*)(lds + LDS_MISC));
    if (IN(0)) { ph_prep_ada(p, lds); if (BOTH(0)) xcd_barrier(bar); }
    if (IN(1)) { if (blockIdx.x & 1) { ph_prep(p, lds); ph_h(p); } else { ph_h(p); ph_prep(p, lds); }
                 if (BOTH(1)) xcd_barrier(bar); }
    if (IN(2)) { ph_inproj(p, lds); if (BOTH(2)) xcd_barrier(bar); }
    if (IN(3)) { ph_gmlp_kv(p, lds); if (BOTH(3)) xcd_barrier(bar); }
    if (IN(4)) { ph_attn(p, lds); if (IN(6)) xcd_barrier(bar); }
    if (IN(6)) { if (blockIdx.x & 1) ph_convert_chunk(p, lds, 256 + (int)blockIdx.x); ph_outproj(p, lds); if (!(blockIdx.x & 1)) ph_convert_chunk(p, lds, 256 + (int)blockIdx.x); if (BOTH(6)) xcd_barrier(bar); }
    if (IN(7)) { if (blockIdx.x & 1) { ph_route(p, lds); __syncthreads(); ph_prep_experts(p, lds); } else { ph_prep_experts(p, lds); __syncthreads(); ph_route(p, lds); }
                 if (BOTH(7)) xcd_barrier(bar); }
    if (IN(8)) { ph_moe1(p, lds); if (BOTH(8)) xcd_barrier(bar); }
    if (IN(9)) { ph_moe2(p, lds); if (BOTH(9)) xcd_barrier(bar); }
    if (IN(10)) ph_final(p);
#undef BOTH
#undef IN
}

extern "C" void kernel_launch(void* const* d_in, const int* in_sizes, int n_in, void* d_out, int out_size, void* d_ws, size_t ws_size, hipStream_t stream) {
    static int grid = 0;
    if (grid == 0) {
        if (n_in != 27 || out_size != NT * DM || ws_size < WS_END) { fprintf(stderr, "kernel_launch: unexpected shapes n_in %d out %d ws %zu\n", n_in, out_size, ws_size); grid = -1; return; }
        int dev = 0, cus = 0;
        if (hipGetDevice(&dev) != hipSuccess || hipDeviceGetAttribute(&cus, hipDeviceAttributeMultiprocessorCount, dev) != hipSuccess) { grid = -1; return; }
        if (hipFuncSetAttribute((const void*)mk_fwd, hipFuncAttributeMaxDynamicSharedMemorySize, LDS_BYTES) != hipSuccess) { fprintf(stderr, "kernel_launch: hipFuncSetAttribute failed\n"); grid = -1; return; }
        grid = 256;
        if (cus != 256) fprintf(stderr, "kernel_launch: %d CUs reported; this kernel is built for a 256-CU device\n", cus);
    }
    if (grid < 0) return;
    (void)hipMemsetAsync((char*)d_ws + WS_CTL, 0, CTL_BYTES, stream);
    P p{};
    p.x = (const float*)d_in[0]; p.c = (const float*)d_in[1]; p.pos = (const int*)d_in[2];
    p.w_ada = (const float*)d_in[3]; p.b_ada = (const float*)d_in[4]; p.norm1_g = (const float*)d_in[5]; p.w_in = (const float*)d_in[6];
    p.v_norm_g = (const float*)d_in[7]; p.v_norm_b = (const float*)d_in[8]; p.w_sp = (const float*)d_in[9]; p.b_sp = (const float*)d_in[10];
    p.kv_norm_g = (const float*)d_in[11]; p.w_uk = (const float*)d_in[12]; p.w_uv = (const float*)d_in[13]; p.kidx_norm_g = (const float*)d_in[14];
    p.gnorm_a_g = (const float*)d_in[15]; p.gnorm_b_g = (const float*)d_in[16]; p.w_out = (const float*)d_in[17]; p.norm2_g = (const float*)d_in[18];
    p.w_group = (const float*)d_in[19]; p.b_group = (const float*)d_in[20]; p.w_expert = (const float*)d_in[21]; p.b_expert = (const float*)d_in[22];
    p.w1 = (const float*)d_in[23]; p.w3 = (const float*)d_in[24]; p.w2 = (const float*)d_in[25]; p.final_g = (const float*)d_in[26];
    p.out = (float*)d_out; p.ws = (unsigned char*)d_ws;
    for (int i = 0; i < 32; ++i) p.freqs[i] = (float)pow(10000.0, -(double)i / 32.0);
    p.ph_lo = 0; p.ph_hi = 11;
    hipLaunchKernelGGL(mk_fwd, dim3(grid), dim3(512), LDS_BYTES, stream, p);
}
```
